# Optimizing an MI355X kernel written in HIP

```python
import math, functools
import jax, jax.numpy as jnp
from jax import lax
import numpy as np

D_MODEL = 1024
BATCH = 1
SEQ = 16384
DEPTH = 4

D_FF = ((8 * D_MODEL // 3 + 127) // 128) * 128
FFN_HALF = 0.5
N_SUB = 3

ML_HEADS = 4
ML_QK = D_MODEL // 2
ML_V = D_MODEL
ML_DK = ML_QK // ML_HEADS
ML_DV = ML_V // ML_HEADS
ML_CHUNK = 64
ML_IN = 2 * ML_QK + 2 * ML_V + 2 * ML_HEADS

MB_EXPAND = 2
MB_DI = MB_EXPAND * D_MODEL
MB_HEADDIM = 64
MB_HEADS = MB_DI // MB_HEADDIM
MB_GROUPS = 4
MB_HPG = MB_HEADS // MB_GROUPS
MB_STATE = 128
MB_CONV = 4
MB_CHUNK = 128
MB_CONV_DIM = MB_DI + 2 * MB_GROUPS * MB_STATE
MB_IN = 2 * MB_DI + 2 * MB_GROUPS * MB_STATE + MB_HEADS

N_MLSTM_LAYERS = (DEPTH + 1) // 2
N_MAMBA_LAYERS = DEPTH // 2
EPS = 1e-6

kernel_name = "hybrid_mlstm_mamba2_macaron_adaln"


def rms_norm(x, g):
    xf = x.astype(jnp.float32)
    y = xf * lax.rsqrt(jnp.mean(xf * xf, axis=-1, keepdims=True) + EPS)
    return (y * g.astype(jnp.float32)).astype(x.dtype)


def _to_chunks(t, L):
    B, S = t.shape[:2]
    return jnp.moveaxis(t.reshape(B, S // L, L, *t.shape[2:]), 1, 0)


def _mlstm_chunk(carry, xs):
    C, n, m = carry
    q, k, v, ig, lf = xs
    L = q.shape[2]
    causal = jnp.tril(jnp.ones((L, L), dtype=bool))
    b = jnp.cumsum(lf, axis=-1)
    log_d = jnp.where(causal, b[..., :, None] - b[..., None, :] + ig[..., None, :], -jnp.inf)
    m_inter = b + m[..., None]
    m_t = jnp.maximum(jnp.max(log_d, axis=-1), m_inter)
    s = jnp.einsum('bhtd,bhsd->bhts', q, k) * jnp.exp(log_d - m_t[..., None])
    inter = jnp.exp(m_inter - m_t)
    num = jnp.einsum('bhts,bhsv->bhtv', s, v) + inter[..., None] * jnp.einsum('bhtd,bhdv->bhtv', q, C)
    den = jnp.sum(s, axis=-1) + inter * jnp.einsum('bhtd,bhd->bht', q, n)
    h = num / jnp.maximum(jnp.abs(den), jnp.exp(-m_t))[..., None]
    b_last = b[..., -1]
    log_w = b_last[..., None] - b + ig
    m_new = jnp.maximum(b_last + m, jnp.max(log_w, axis=-1))
    w = jnp.exp(log_w - m_new[..., None])
    decay = jnp.exp(b_last + m - m_new)
    C_new = decay[..., None, None] * C + jnp.einsum('bhs,bhsd,bhsv->bhdv', w, k, v)
    n_new = decay[..., None] * n + jnp.einsum('bhs,bhsd->bhd', w, k)
    return (C_new, n_new, m_new), h


def mlstm_mixer(h, w_in, b_gate, norm_w, w_out):
    B, S, _ = h.shape
    proj = h @ w_in
    q, k, v, o, gates = jnp.split(proj, [ML_QK, 2 * ML_QK, 2 * ML_QK + ML_V, 2 * ML_QK + 2 * ML_V], axis=-1)
    f32 = jnp.float32
    q = q.reshape(B, S, ML_HEADS, ML_DK).astype(f32)
    k = k.reshape(B, S, ML_HEADS, ML_DK).astype(f32) * (ML_DK ** -0.5)
    v = v.reshape(B, S, ML_HEADS, ML_DV).astype(f32)
    gates = gates.astype(f32) + b_gate.astype(f32)
    ig, fg = jnp.split(gates, 2, axis=-1)
    lf = jax.nn.log_sigmoid(fg)
    xs = tuple(jnp.swapaxes(_to_chunks(t, ML_CHUNK), 2, 3) for t in (q, k, v, ig, lf))
    carry0 = (jnp.zeros((B, ML_HEADS, ML_DK, ML_DV), f32),
              jnp.zeros((B, ML_HEADS, ML_DK), f32),
              jnp.zeros((B, ML_HEADS), f32))
    _, hs = lax.scan(_mlstm_chunk, carry0, xs)
    hs = jnp.moveaxis(jnp.swapaxes(hs, 2, 3), 0, 1).reshape(B, S, ML_HEADS, ML_DV)
    hs = hs * lax.rsqrt(jnp.mean(hs * hs, axis=-1, keepdims=True) + EPS)
    hs = hs.reshape(B, S, ML_V) * norm_w.astype(f32) * jax.nn.sigmoid(o.astype(f32))
    return hs.astype(h.dtype) @ w_out


def _ssd_chunk(state, xs, A):
    x, dt, Bc, Cc = xs
    Q = x.shape[1]
    causal = jnp.tril(jnp.ones((Q, Q), dtype=bool))
    a = jnp.cumsum(dt * A, axis=1)
    seg = jnp.where(causal[None, :, :, None, None], a[:, :, None] - a[:, None, :], -jnp.inf)
    w = jnp.einsum('btgn,bsgn->btsg', Cc, Bc)[..., None] * jnp.exp(seg) * dt[:, None]
    y = (jnp.einsum('btsgh,bsghp->btghp', w, x)
         + jnp.exp(a)[..., None] * jnp.einsum('btgn,bghpn->btghp', Cc, state))
    a_last = a[:, -1]
    ws = jnp.exp(a_last[:, None] - a) * dt
    state_new = (jnp.exp(a_last)[..., None, None] * state
                 + jnp.einsum('bsgn,bsgh,bsghp->bghpn', Bc, ws, x))
    return state_new, y


def mamba2_mixer(h, w_in, conv_w, conv_b, dt_bias, A_log, D_skip, norm_w, w_out):
    B, S, _ = h.shape
    f32 = jnp.float32
    proj = h @ w_in
    z, xbc, dt = jnp.split(proj, [MB_DI, MB_DI + MB_CONV_DIM], axis=-1)
    xbc = lax.conv_general_dilated(xbc, conv_w[:, None, :].astype(xbc.dtype), window_strides=(1,),
                                   padding=[(MB_CONV - 1, 0)], dimension_numbers=('NWC', 'WIO', 'NWC'),
                                   feature_group_count=MB_CONV_DIM)
    xbc = jax.nn.silu((xbc + conv_b).astype(f32))
    xs, Bm, Cm = jnp.split(xbc, [MB_DI, MB_DI + MB_GROUPS * MB_STATE], axis=-1)
    xs = xs.reshape(B, S, MB_GROUPS, MB_HPG, MB_HEADDIM)
    Bm = Bm.reshape(B, S, MB_GROUPS, MB_STATE)
    Cm = Cm.reshape(B, S, MB_GROUPS, MB_STATE)
    dt = jax.nn.softplus(dt.astype(f32) + dt_bias.astype(f32)).reshape(B, S, MB_GROUPS, MB_HPG)
    A = -jnp.exp(A_log.astype(f32)).reshape(MB_GROUPS, MB_HPG)
    chunks = tuple(_to_chunks(t, MB_CHUNK) for t in (xs, dt, Bm, Cm))
    state0 = jnp.zeros((B, MB_GROUPS, MB_HPG, MB_HEADDIM, MB_STATE), f32)
    _, ys = lax.scan(functools.partial(_ssd_chunk, A=A), state0, chunks)
    y = jnp.moveaxis(ys, 0, 1).reshape(B, S, MB_GROUPS, MB_HPG, MB_HEADDIM)
    y = y + D_skip.astype(f32).reshape(MB_GROUPS, MB_HPG)[..., None] * xs
    y = y.reshape(B, S, MB_DI) * jax.nn.silu(z.astype(f32))
    y = y.reshape(B, S, MB_GROUPS, MB_DI // MB_GROUPS)
    y = y * lax.rsqrt(jnp.mean(y * y, axis=-1, keepdims=True) + EPS)
    y = y.reshape(B, S, MB_DI) * norm_w.astype(f32)
    return y.astype(h.dtype) @ w_out


def swiglu(h, w1, w3, w2):
    return (jax.nn.silu(h @ w1) * (h @ w3)) @ w2


def sublayer(x, fn, g_pre, g_post, shift, scale, gate, weight):
    hmod = rms_norm(x, g_pre) * (1 + scale[:, None, :]) + shift[:, None, :]
    y = rms_norm(fn(hmod), g_post)
    return x + weight * gate[:, None, :] * y


def setup_inputs(seed: int = 0) -> dict:
    key = jax.random.key(seed)
    ks = jax.random.split(key, 24)
    D = D_MODEL
    nrm = lambda k, shape, fan_in: jax.random.normal(k, shape, jnp.float32) * (fan_in ** -0.5)
    u_dt = jax.random.uniform(ks[17], (N_MAMBA_LAYERS, MB_HEADS), jnp.float32)
    dt0 = jnp.exp(u_dt * (math.log(0.1) - math.log(1e-3)) + math.log(1e-3))
    ig_b = 0.5 * jax.random.normal(ks[12], (N_MLSTM_LAYERS, ML_HEADS), jnp.float32)
    fg_b = 3.0 + 3.0 * jax.random.uniform(ks[13], (N_MLSTM_LAYERS, ML_HEADS), jnp.float32)
    return {
        "x": jax.random.normal(ks[0], (BATCH, SEQ, D), jnp.float32),
        "c": jax.random.normal(ks[1], (BATCH, D), jnp.float32),
        "ada_w": 0.5 * nrm(ks[2], (DEPTH, D, 3 * N_SUB * D), D),
        "ada_b": 0.02 * jax.random.normal(ks[3], (DEPTH, 3 * N_SUB * D), jnp.float32),
        "norm_pre": 1.0 + 0.1 * jax.random.normal(ks[4], (DEPTH, N_SUB, D), jnp.float32),
        "norm_post": 1.0 + 0.1 * jax.random.normal(ks[5], (DEPTH, N_SUB, D), jnp.float32),
        "ffn_w1": nrm(ks[6], (DEPTH, 2, D, D_FF), D),
        "ffn_w3": nrm(ks[7], (DEPTH, 2, D, D_FF), D),
        "ffn_w2": nrm(ks[8], (DEPTH, 2, D_FF, D), D_FF),
        "ml_w_in": nrm(ks[9], (N_MLSTM_LAYERS, D, ML_IN), D),
        "ml_b_gate": jnp.concatenate([ig_b, fg_b], axis=-1),
        "ml_norm_w": 1.0 + 0.1 * jax.random.normal(ks[10], (N_MLSTM_LAYERS, ML_V), jnp.float32),
        "ml_w_out": nrm(ks[11], (N_MLSTM_LAYERS, ML_V, D), ML_V),
        "mb_w_in": nrm(ks[14], (N_MAMBA_LAYERS, D, MB_IN), D),
        "mb_conv_w": nrm(ks[15], (N_MAMBA_LAYERS, MB_CONV, MB_CONV_DIM), MB_CONV),
        "mb_conv_b": 0.02 * jax.random.normal(ks[16], (N_MAMBA_LAYERS, MB_CONV_DIM), jnp.float32),
        "mb_dt_bias": dt0 + jnp.log(-jnp.expm1(-dt0)),
        "mb_A_log": jnp.log(jax.random.uniform(ks[18], (N_MAMBA_LAYERS, MB_HEADS), jnp.float32, 1.0, 16.0)),
        "mb_D": 1.0 + 0.1 * jax.random.normal(ks[19], (N_MAMBA_LAYERS, MB_HEADS), jnp.float32),
        "mb_norm_w": 1.0 + 0.1 * jax.random.normal(ks[20], (N_MAMBA_LAYERS, MB_DI), jnp.float32),
        "mb_w_out": nrm(ks[21], (N_MAMBA_LAYERS, MB_DI, D), MB_DI),
    }


def reference(x, c, ada_w, ada_b, norm_pre, norm_post, ffn_w1, ffn_w3, ffn_w2,
              ml_w_in, ml_b_gate, ml_norm_w, ml_w_out,
              mb_w_in, mb_conv_w, mb_conv_b, mb_dt_bias, mb_A_log, mb_D, mb_norm_w, mb_w_out):
    B = x.shape[0]
    c_act = jax.nn.silu(c)
    for i in range(DEPTH):
        mod = (c_act @ ada_w[i] + ada_b[i]).reshape(B, N_SUB, 3, D_MODEL)
        j = i // 2
        if i % 2 == 0:
            mixer = lambda h, j=j: mlstm_mixer(h, ml_w_in[j], ml_b_gate[j], ml_norm_w[j], ml_w_out[j])
        else:
            mixer = lambda h, j=j: mamba2_mixer(h, mb_w_in[j], mb_conv_w[j], mb_conv_b[j], mb_dt_bias[j],
                                                mb_A_log[j], mb_D[j], mb_norm_w[j], mb_w_out[j])
        fns = (lambda h, i=i: swiglu(h, ffn_w1[i, 0], ffn_w3[i, 0], ffn_w2[i, 0]),
               mixer,
               lambda h, i=i: swiglu(h, ffn_w1[i, 1], ffn_w3[i, 1], ffn_w2[i, 1]))
        weights = (FFN_HALF, 1.0, FFN_HALF)
        for s in range(N_SUB):
            x = sublayer(x, fns[s], norm_pre[i, s], norm_post[i, s],
                         mod[:, s, 0], mod[:, s, 1], mod[:, s, 2], weights[s])
    return x
```

```cpp
#include <hip/hip_runtime.h>
#include <hip/hip_cooperative_groups.h>
#include <cstdio>
#include <cstdint>
namespace cg = cooperative_groups;
__device__ __forceinline__ int tid_opaque() { int t = threadIdx.x; asm volatile("" : "+v"(t)); return t; }
namespace pg8 {
#define PG8_LAS __attribute__((address_space(3)))
typedef unsigned short bf16_t;
typedef short bf16x8 __attribute__((ext_vector_type(8)));
typedef float f32x4 __attribute__((ext_vector_type(4)));
typedef unsigned u32x4 __attribute__((ext_vector_type(4)));
constexpr int BM = 256, BK = 64, HALF = 128, HTB = HALF * BK * 2  , STAGE_BYTES = 8 * HTB, NXCD = 8, WGM = 8;

__host__ __device__ __forceinline__ int lds_byte(int r, int c) { const int st = (r >> 4) * 2 + (c >> 5), rr = r & 15, cc = c & 31, ob = rr * 64 + cc * 2; return st * 1024 + (ob ^ (((ob >> 9) & 1) << 5)); }
__host__ __device__ __forceinline__ void stage_rc(int b, int& R, int& C) { const int st = b / 1024, sb = b % 1024, swz = sb ^ (((sb >> 9) & 1) << 5); R = (st >> 1) * 16 + swz / 64; C = (st & 1) * 32 + (swz % 64) / 2; }
__host__ __device__ __forceinline__ int perm32(int rho) { const int n = rho >> 4, i = rho & 15; return 8 * (i >> 2) + 4 * n + (i & 3); }

struct Unit { int pm, pn; };
struct Gemm { const bf16_t* A; const bf16_t* Bt; int M, N, K; };

struct StaticOrder {
    int nM, nN, nwg, G, c;
    __host__ __device__ void init(int M, int N, int G_, int c_) { nM = M / BM; nN = N / BM; nwg = nM * nN; G = G_; c = c_; }
    __host__ __device__ bool next(int i, Unit& u) const {
        const long L = (long)i * G + c; if (L >= nwg) return false;
        int wgid = (int)L; { const int q = nwg / NXCD, r = nwg % NXCD, xcd = wgid % NXCD, off = wgid / NXCD; wgid = (xcd < r ? xcd * (q + 1) : r * (q + 1) + (xcd - r) * q) + off; }
        const int nig = WGM * nN, gid = wgid / nig, fm = gid * WGM, gsz = (nM - fm) < WGM ? (nM - fm) : WGM;
        u.pm = fm + ((wgid % nig) % gsz); u.pn = (wgid % nig) / gsz; return true;
    }
    __device__ __forceinline__ void a_ready(const Unit&) const {}
    __device__ __forceinline__ void done(const Unit&) const {}
};

typedef __bf16 bf16v2_t __attribute__((ext_vector_type(2))); typedef float f32v2_t __attribute__((ext_vector_type(2)));
__device__ __forceinline__ unsigned cvt_pk_bf16(float lo, float hi) { f32v2_t v = {lo, hi}; bf16v2_t b = __builtin_convertvector(v, bf16v2_t); return __builtin_bit_cast(unsigned, b); }
typedef float f32x2 __attribute__((ext_vector_type(2)));
__device__ __forceinline__ float silu_f(float x) { return x * __builtin_amdgcn_rcpf(1.0f + __builtin_amdgcn_exp2f(-1.4426950408889634f * x)); }
struct EpiStoreBf16 {
    static constexpr bool PERM = true, AFTER_DRAIN = false;
    bf16_t* O; int ldc;
    __device__ __forceinline__ void operator()(const f32x4 (&acc)[2][2][4][2], const Unit& u, int wr, int wc, int fr, int fq) const {
        const int row0 = u.pm * BM + wr * 64 + fr; const int col0 = u.pn * BM + wc * 32 + 8 * fq;
#pragma unroll
        for (int ai = 0; ai < 2; ++ai)
#pragma unroll
            for (int m = 0; m < 4; ++m) { bf16_t* rowp = O + (size_t)(row0 + ai * HALF + m * 16) * ldc + col0;
#pragma unroll
                for (int bj = 0; bj < 2; ++bj) { const f32x4 v0 = acc[ai][bj][m][0], v1 = acc[ai][bj][m][1];
                    u32x4 w; w.x = cvt_pk_bf16(v0[0], v0[1]); w.y = cvt_pk_bf16(v0[2], v0[3]); w.z = cvt_pk_bf16(v1[0], v1[1]); w.w = cvt_pk_bf16(v1[2], v1[3]);
                    *(u32x4*)(rowp + bj * HALF) = w; } }
    }
};
struct EpiSwiGLU {
    static constexpr bool PERM = true, AFTER_DRAIN = false;
    bf16_t* O; int ldc;
    __device__ __forceinline__ void operator()(const f32x4 (&acc)[2][2][4][2], const Unit& u, int wr, int wc, int fr, int fq) const {
        const int row0 = u.pm * BM + wr * 64 + fr; const int col0 = u.pn * HALF + wc * 32 + 8 * fq;
#pragma unroll
        for (int ai = 0; ai < 2; ++ai)
#pragma unroll
            for (int m = 0; m < 4; ++m) { bf16_t* rowp = O + (size_t)(row0 + ai * HALF + m * 16) * ldc + col0;
                const f32x4 a0 = acc[ai][0][m][0], a1 = acc[ai][0][m][1], b0 = acc[ai][1][m][0], b1 = acc[ai][1][m][1];
                u32x4 w; w.x = cvt_pk_bf16(silu_f(a0[0]) * b0[0], silu_f(a0[1]) * b0[1]); w.y = cvt_pk_bf16(silu_f(a0[2]) * b0[2], silu_f(a0[3]) * b0[3]);
                w.z = cvt_pk_bf16(silu_f(a1[0]) * b1[0], silu_f(a1[1]) * b1[1]); w.w = cvt_pk_bf16(silu_f(a1[2]) * b1[2], silu_f(a1[3]) * b1[3]);
                *(u32x4*)rowp = w; }
    }
};
struct EpiStoreF32 {
    static constexpr bool PERM = false, AFTER_DRAIN = false;
    float* Y; int ldc;
    __device__ __forceinline__ void operator()(const f32x4 (&acc)[2][2][4][2], const Unit& u, int wr, int wc, int fr, int fq) const {
        const int row0 = u.pm * BM + wr * 64 + fr; const int col0 = u.pn * BM + wc * 32 + 4 * fq;
#pragma unroll
        for (int ai = 0; ai < 2; ++ai)
#pragma unroll
            for (int m = 0; m < 4; ++m) { float* rowp = Y + (size_t)(row0 + ai * HALF + m * 16) * ldc + col0;
#pragma unroll
                for (int bj = 0; bj < 2; ++bj)
#pragma unroll
                    for (int n = 0; n < 2; ++n) *(f32x4*)(rowp + bj * HALF + n * 16) = acc[ai][bj][m][n]; }
    }
};
template <class Epi, class Sched, bool ALIGN_EPI = false, bool SP2 = false>
__device__ __forceinline__ void gemm_phase(PG8_LAS unsigned char* lds, const Gemm g, const Sched& S, const Epi& E) {
    const int tid = tid_opaque(), wid = __builtin_amdgcn_readfirstlane(tid >> 6), lane = tid & 63, wr = wid >> 2, wc = wid & 3, fr = lane & 15, fq = lane >> 4;
    const int K = g.K, nt = K / BK;
    unsigned voffA[2], voffB[2];
#pragma unroll
    for (int i = 0; i < 2; ++i) { int R, C; stage_rc(tid * 16 + i * 8192, R, C); const int Rb = Epi::PERM ? ((R & ~31) + perm32(R & 31)) : R;
        voffA[i] = (unsigned)(R * K + C) * 2u; voffB[i] = (unsigned)(Rb * K + C) * 2u; }
    const size_t kstep = (size_t)(BK * 2);
    const size_t hstep = (size_t)HALF * K * 2;
    const size_t tstep = 2 * hstep;
    const unsigned ldsw = (unsigned)wid * 1024u;
    const int aoff = lds_byte(wr * 64 + fr, fq * 8), boff = lds_byte(wc * 32 + fr, fq * 8);
#define PG8_SA(b, h) (((b) * 2 + (h)) * HTB)
#define PG8_SB(b, h) ((4 + (b) * 2 + (h)) * HTB)
#define PG8_STAGE(bufoff, gbase, voff) do { _Pragma("unroll") for (int _i = 0; _i < 2; ++_i) \
        __builtin_amdgcn_global_load_lds((const unsigned*)((const char*)(gbase) + (voff)[_i]), (PG8_LAS unsigned*)(lds + (bufoff) + ldsw + _i * 8192), 16, 0, 0); } while (0)
#define PG8_LDA(dst, b, h) do { _Pragma("unroll") for (int m = 0; m < 4; ++m) _Pragma("unroll") for (int k = 0; k < 2; ++k) dst[m][k] = *(const PG8_LAS bf16x8*)(lds + PG8_SA(b, h) + aoff + m * 2048 + k * 1024); } while (0)
#define PG8_LDB(dst, b, h) do { _Pragma("unroll") for (int n = 0; n < 2; ++n) _Pragma("unroll") for (int k = 0; k < 2; ++k) dst[n][k] = *(const PG8_LAS bf16x8*)(lds + PG8_SB(b, h) + boff + n * 2048 + k * 1024); } while (0)
#define PG8_MMA(ai, bj, At, Bt) do { __builtin_amdgcn_s_setprio(1); _Pragma("unroll") for (int m = 0; m < 4; ++m) _Pragma("unroll") for (int n = 0; n < 2; ++n) _Pragma("unroll") for (int k = 0; k < 2; ++k) \
        acc[ai][bj][m][n] = __builtin_amdgcn_mfma_f32_16x16x32_bf16(Bt[n][k], At[m][k], acc[ai][bj][m][n], 0, 0, 0); __builtin_amdgcn_s_setprio(0); } while (0)
#define PG8_WAIT_V(n) asm volatile("s_waitcnt vmcnt(" #n ")" ::: "memory")
#define PG8_WAIT_L(n) asm volatile("s_waitcnt lgkmcnt(" #n ")" ::: "memory")
#define PG8_BAR __builtin_amdgcn_s_barrier()
#define PG8_SCHED __builtin_amdgcn_sched_barrier(0)
    Unit cur, nxt; int ui = 0;
    if (!S.next(0, cur)) return;
    f32x4 acc[2][2][4][2];
#pragma unroll
    for (int a = 0; a < 2; ++a)
#pragma unroll
        for (int b = 0; b < 2; ++b)
#pragma unroll
            for (int m = 0; m < 4; ++m)
#pragma unroll
                for (int n = 0; n < 2; ++n) acc[a][b][m][n] = (f32x4){0.f, 0.f, 0.f, 0.f};
    bf16x8 At[4][2], B0[2][2], B1[2][2];
    const char* cA = (const char*)g.A + (size_t)cur.pm * tstep; const char* cB = (const char*)g.Bt + (size_t)cur.pn * tstep;
    S.a_ready(cur);
    if constexpr (SP2) {
        PG8_STAGE(PG8_SB(0, 0), cB, voffB); PG8_STAGE(PG8_SB(0, 1), cB + hstep, voffB); PG8_STAGE(PG8_SA(0, 0), cA, voffA); PG8_STAGE(PG8_SA(0, 1), cA + hstep, voffA);
        if (wr == 1) PG8_BAR;
        PG8_WAIT_V(2); PG8_BAR;
        PG8_STAGE(PG8_SB(1, 0), cB + kstep, voffB); PG8_STAGE(PG8_SA(1, 0), cA + kstep, voffA); PG8_STAGE(PG8_SB(1, 1), cB + hstep + kstep, voffB);
        PG8_WAIT_V(6); PG8_BAR;
    } else {
        PG8_STAGE(PG8_SB(0, 0), cB, voffB); PG8_STAGE(PG8_SA(0, 0), cA, voffA); PG8_STAGE(PG8_SB(0, 1), cB + hstep, voffB); PG8_STAGE(PG8_SA(0, 1), cA + hstep, voffA);
        if (wr == 1) PG8_BAR;
        PG8_WAIT_V(4); PG8_BAR;
        PG8_STAGE(PG8_SB(1, 0), cB + kstep, voffB); PG8_STAGE(PG8_SA(1, 0), cA + kstep, voffA); PG8_STAGE(PG8_SB(1, 1), cB + hstep + kstep, voffB);
        PG8_WAIT_V(6); PG8_BAR;
    }
    for (;;) {
        const bool has_next = S.next(ui + 1, nxt);
        const char* nA = has_next ? (const char*)g.A + (size_t)nxt.pm * tstep : cA; const char* nB = has_next ? (const char*)g.Bt + (size_t)nxt.pn * tstep : cB;
        for (int t = 0; t < nt; t += 2) {
            const bool last = (t == nt - 2);
            const char* a1 = cA + (size_t)(t + 1) * kstep;
            const char* a2 = last ? nA : cA + (size_t)(t + 2) * kstep; const char* b2 = last ? nB : cB + (size_t)(t + 2) * kstep;
            const char* a3 = a2 + kstep; const char* b3 = b2 + kstep;
            if (last && has_next) S.a_ready(nxt);
            if constexpr (SP2) {
            PG8_LDB(B0, 0, 0); PG8_LDB(B1, 0, 1); PG8_SCHED; PG8_LDA(At, 0, 0); PG8_STAGE(PG8_SA(1, 1), a1 + hstep, voffA);
            PG8_WAIT_V(8); PG8_WAIT_L(0); PG8_BAR; PG8_MMA(0, 0, At, B0); PG8_MMA(0, 1, At, B1); PG8_BAR; PG8_SCHED;
            PG8_LDA(At, 0, 1); PG8_STAGE(PG8_SB(0, 0), b2, voffB); PG8_STAGE(PG8_SB(0, 1), b2 + hstep, voffB); PG8_STAGE(PG8_SA(0, 0), a2, voffA);
            PG8_WAIT_V(8); PG8_WAIT_L(0); PG8_BAR; PG8_MMA(1, 0, At, B0); PG8_MMA(1, 1, At, B1); PG8_BAR; PG8_SCHED;
            PG8_LDB(B0, 1, 0); PG8_LDB(B1, 1, 1); PG8_SCHED; PG8_LDA(At, 1, 0); PG8_STAGE(PG8_SA(0, 1), a2 + hstep, voffA);
            PG8_WAIT_V(8); PG8_WAIT_L(0); PG8_BAR; PG8_MMA(0, 0, At, B0); PG8_MMA(0, 1, At, B1); PG8_BAR; PG8_SCHED;
            PG8_LDA(At, 1, 1); PG8_STAGE(PG8_SB(1, 0), b3, voffB); PG8_STAGE(PG8_SB(1, 1), b3 + hstep, voffB); PG8_STAGE(PG8_SA(1, 0), a3, voffA);
            PG8_WAIT_V(8); PG8_WAIT_L(0); PG8_BAR; PG8_MMA(1, 0, At, B0); PG8_MMA(1, 1, At, B1); PG8_BAR; PG8_SCHED;
            } else {
            PG8_LDB(B0, 0, 0); PG8_SCHED; PG8_LDA(At, 0, 0); PG8_STAGE(PG8_SA(1, 1), a1 + hstep, voffA);
            PG8_WAIT_L(8); PG8_BAR; PG8_WAIT_L(0); PG8_MMA(0, 0, At, B0); PG8_BAR; PG8_SCHED;
            PG8_LDB(B1, 0, 1); PG8_STAGE(PG8_SB(0, 0), b2, voffB);
            PG8_BAR; PG8_WAIT_L(0); PG8_MMA(0, 1, At, B1); PG8_BAR;
            PG8_LDA(At, 0, 1); PG8_STAGE(PG8_SA(0, 0), a2, voffA);
            PG8_BAR; PG8_WAIT_L(0); PG8_MMA(1, 0, At, B0); PG8_BAR; PG8_SCHED;
            PG8_STAGE(PG8_SB(0, 1), b2 + hstep, voffB);
            PG8_WAIT_V(6); PG8_BAR; PG8_MMA(1, 1, At, B1); PG8_BAR;
            PG8_LDB(B0, 1, 0); PG8_SCHED; PG8_LDA(At, 1, 0); PG8_STAGE(PG8_SA(0, 1), a2 + hstep, voffA);
            PG8_WAIT_L(8); PG8_BAR; PG8_WAIT_L(0); PG8_MMA(0, 0, At, B0); PG8_BAR; PG8_SCHED;
            PG8_LDB(B1, 1, 1); PG8_STAGE(PG8_SB(1, 0), b3, voffB);
            PG8_BAR; PG8_WAIT_L(0); PG8_MMA(0, 1, At, B1); PG8_BAR;
            PG8_LDA(At, 1, 1); PG8_STAGE(PG8_SA(1, 0), a3, voffA);
            PG8_BAR; PG8_WAIT_L(0); PG8_MMA(1, 0, At, B0); PG8_BAR; PG8_SCHED;
            PG8_STAGE(PG8_SB(1, 1), b3 + hstep, voffB);
            PG8_WAIT_V(6); PG8_BAR; PG8_MMA(1, 1, At, B1); PG8_BAR;
            }
        }
        if constexpr (ALIGN_EPI) { if (wr == 0) PG8_BAR; }
        if constexpr (!Epi::AFTER_DRAIN) { E(acc, cur, wr, wc, fr, fq); S.done(cur); }
        if (!has_next) break;
#pragma unroll
        for (int a = 0; a < 2; ++a)
#pragma unroll
            for (int b = 0; b < 2; ++b)
#pragma unroll
                for (int m = 0; m < 4; ++m)
#pragma unroll
                    for (int n = 0; n < 2; ++n) acc[a][b][m][n] = (f32x4){0.f, 0.f, 0.f, 0.f};
        cur = nxt; cA = nA; cB = nB; ++ui;
        if constexpr (ALIGN_EPI) { if (wr == 1) PG8_BAR; }
    }
    PG8_WAIT_V(0);
    if constexpr (!ALIGN_EPI) { if (wr == 0) PG8_BAR; }
    PG8_BAR;
    if constexpr (Epi::AFTER_DRAIN) { E.fused(acc, cur, wr, wc, fr, fq, lds, wid, lane); S.done(cur); }
#undef PG8_SA
#undef PG8_SB
#undef PG8_STAGE
#undef PG8_LDA
#undef PG8_LDB
#undef PG8_MMA
#undef PG8_WAIT_V
#undef PG8_WAIT_L
#undef PG8_BAR
#undef PG8_SCHED
}
}

#define LAS __attribute__((address_space(3)))
typedef unsigned short bf16;
typedef short bf16x8 __attribute__((ext_vector_type(8)));
typedef float f32x4 __attribute__((ext_vector_type(4)));
typedef unsigned u32x4 __attribute__((ext_vector_type(4)));
typedef unsigned u32x2 __attribute__((ext_vector_type(2)));

constexpr int S = 16384, D = 1024, DFF = 2816;
constexpr int ML_N = 3072, ML_LD = 3080;
constexpr int MB_N = 5376, MB_SRC = 5152, MB_DI = 2048;
constexpr float EPS = 1e-6f;
constexpr size_t MiB = (size_t)1 << 20;
constexpr size_t WS_MOD = 0;
constexpr size_t WS_GATES = 1 * MiB;
constexpr size_t WS_MISC = 2 * MiB;
constexpr size_t WS_ACUM = 4 * MiB;
constexpr size_t WS_DT = 6 * MiB;
constexpr size_t WS_W = 8 * MiB;
constexpr size_t FFN_UP_B = (size_t)2 * DFF * D * 2, FFN_DN_B = (size_t)D * DFF * 2, FFN_B = FFN_UP_B + FFN_DN_B;
constexpr size_t ML_IN_B = (size_t)ML_N * D * 2, ML_OUT_B = (size_t)D * D * 2, MB_IN_B = (size_t)MB_N * D * 2, MB_OUT_B = (size_t)D * MB_DI * 2;
constexpr size_t WS_W_ML_IN = WS_W + 8 * FFN_B;
constexpr size_t WS_W_ML_OUT = WS_W_ML_IN + 2 * ML_IN_B;
constexpr size_t WS_W_MB_IN = WS_W_ML_OUT + 2 * ML_OUT_B;
constexpr size_t WS_W_MB_OUT = WS_W_MB_IN + 2 * MB_IN_B;
constexpr size_t WS_W_END = WS_W_MB_OUT + 2 * MB_OUT_B;
constexpr size_t WS_HM = 186 * MiB;
constexpr size_t WS_PROJ = 250 * MiB;
constexpr size_t WS_ST = 418 * MiB;
constexpr size_t WS_Y = 482 * MiB;
constexpr size_t WS_END = 546 * MiB;
static_assert(WS_W_END <= WS_HM, "ws map");
constexpr size_t MI_G = 0, MI_A = 4096, MI_M = 8192, MI_NU = 65536  , MI_ALAST = 1 * MiB  ;

constexpr int LDS_BYTES = 147456;

struct Params { const float* in[21]; float* out; unsigned char* ws; };

__device__ __forceinline__ unsigned f2bf(float f) { unsigned u = __float_as_uint(f); return (u + 0x7fffu + ((u >> 16) & 1u)) >> 16; }
__device__ __forceinline__ unsigned pk2(float lo, float hi) { return pg8::cvt_pk_bf16(lo, hi); }
__device__ __forceinline__ float bflo(unsigned w) { return __uint_as_float(w << 16); }
__device__ __forceinline__ float bfhi(unsigned w) { return __uint_as_float(w & 0xffff0000u); }
__device__ __forceinline__ float bf2f(unsigned short b) { return __uint_as_float((unsigned)b << 16); }
__device__ __forceinline__ float wave_sum(float v) {
#pragma unroll
    for (int o = 1; o < 64; o <<= 1) v += __shfl_xor(v, o);
    return v;
}
__device__ __forceinline__ float wave_max(float v) {
#pragma unroll
    for (int o = 1; o < 64; o <<= 1) v = fmaxf(v, __shfl_xor(v, o));
    return v;
}
__device__ __forceinline__ float scan_add(float v, int lane) {
#pragma unroll
    for (int o = 1; o < 64; o <<= 1) { const float t = __shfl_up(v, o); if (lane >= o) v += t; }
    return v;
}
__device__ __forceinline__ float scan_max(float v, int lane) {
#pragma unroll
    for (int o = 1; o < 64; o <<= 1) { const float t = __shfl_up(v, o); if (lane >= o) v = fmaxf(v, t); }
    return v;
}
__device__ __forceinline__ float silu(float x) { return x / (1.0f + __expf(-x)); }
__device__ __forceinline__ float sigmoidf_(float x) { return 1.0f / (1.0f + __expf(-x)); }
__device__ __forceinline__ float softplus_(float x) { return fmaxf(x, 0.f) + log1pf(__expf(-fabsf(x))); }

__device__ __forceinline__ bf16x8 frag_row(const LAS unsigned char* T, int strideB, int r0, int k0, int lane) {
    return *(const LAS bf16x8*)(T + (r0 + (lane & 15)) * strideB + (k0 + 8 * (lane >> 4)) * 2);
}
#ifndef USE_TR
#define USE_TR 1
#endif
__device__ __forceinline__ bf16x8 frag_tr(const LAS unsigned char* T, int strideB, int k0, int c0, int lane) {
#if USE_TR
    const int g = lane >> 4, i = lane & 15, q = i >> 2, p = i & 3;
    const unsigned a0 = (unsigned)(uintptr_t)(T + (k0 + 8 * g + q) * strideB + (c0 + 4 * p) * 2);
    const unsigned a1 = a0 + 4u * (unsigned)strideB;
    u32x2 lo, hi;
    asm volatile("ds_read_b64_tr_b16 %0, %2\n\tds_read_b64_tr_b16 %1, %3\n\ts_waitcnt lgkmcnt(0)" : "=&v"(lo), "=&v"(hi) : "v"(a0), "v"(a1) : "memory");
    u32x4 r; r.x = lo.x; r.y = lo.y; r.z = hi.x; r.w = hi.y;
    return __builtin_bit_cast(bf16x8, r);
#else
    bf16x8 r;
    const LAS unsigned char* p = T + (k0 + 8 * (lane >> 4)) * strideB + (c0 + (lane & 15)) * 2;
#pragma unroll
    for (int e = 0; e < 8; ++e) r[e] = *(const LAS short*)(p + e * strideB);
    return r;
#endif
}
#define MFMA16(b, a, c) __builtin_amdgcn_mfma_f32_16x16x32_bf16((b), (a), (c), 0, 0, 0)

__device__ __forceinline__ void transpose_item(const float* W, int K, int Nld, int Nvalid, bf16* WT, int k0, int n0, int drow0, LAS float* scr, int lane) {
    const bool ok = (n0 + lane) < Nvalid;
    const float* src = W + (size_t)k0 * Nld + n0 + lane;
#pragma unroll 16
    for (int i = 0; i < 64; ++i) scr[i * 65 + lane] = ok ? src[(size_t)i * Nld] : 0.f;
    asm volatile("s_waitcnt lgkmcnt(0)" ::: "memory");
    const int c = lane & 7;
#pragma unroll
    for (int j = 0; j < 8; ++j) {
        const int n = (lane >> 3) + 8 * j; const LAS float* s = scr + (8 * c) * 65 + n;
        u32x4 o; o.x = pk2(s[0], s[65]); o.y = pk2(s[2 * 65], s[3 * 65]); o.z = pk2(s[4 * 65], s[5 * 65]); o.w = pk2(s[6 * 65], s[7 * 65]);
        *(u32x4*)(WT + (size_t)(drow0 + n) * K + k0 + 8 * c) = o;
    }
    asm volatile("s_waitcnt lgkmcnt(0)" ::: "memory");
}

__device__ __forceinline__ void prologue(LAS unsigned char* lds, const Params& P) {
    const int tid = tid_opaque(), lane = tid & 63, wid = tid >> 6;
    unsigned char* ws = P.ws;
    for (int item = blockIdx.x; item < 144; item += gridDim.x) {
        const int i = item / 36, col0 = (item % 36) * 256;
        const float* cvec = P.in[1]; const float* aw = P.in[2] + ((size_t)i * 1024 + wid * 128) * 9216 + col0 + 4 * lane;
        f32x4 acc = {0.f, 0.f, 0.f, 0.f};
#pragma unroll 16
        for (int k = 0; k < 128; ++k) { const float ca = silu(cvec[wid * 128 + k]); const f32x4 w = *(const f32x4*)(aw + (size_t)k * 9216); acc += ca * w; }
        LAS float* red = (LAS float*)lds;
        *(LAS f32x4*)(red + wid * 256 + 4 * lane) = acc;
        __syncthreads();
        if (tid < 256) { float s = P.in[3][i * 9216 + col0 + tid];
#pragma unroll
            for (int w = 0; w < 8; ++w) s += red[w * 256 + tid];
            ((float*)(ws + WS_MOD))[i * 9216 + col0 + tid] = s; }
        __syncthreads();
    }
    LAS float* scr = (LAS float*)(lds + wid * 16640);
    const int gw = blockIdx.x * 8 + wid, NGW = gridDim.x * 8;
    constexpr int I_FFN = 704, N_FFN = 24 * I_FFN, I_MLI = 16 * 48, I_MLO = 16 * 16, I_MBI = 16 * 84, I_MBO = 32 * 16;
    constexpr int NITEMS = N_FFN + 2 * (I_MLI + I_MLO + I_MBI + I_MBO);
    for (int it = gw; it < NITEMS; it += NGW) {
        int r = it;
        if (r < N_FFN) {
            const int job = r / I_FFN, q = r % I_FFN, l = job / 3, which = job % 3;
            bf16* base = (bf16*)(ws + WS_W + (size_t)l * FFN_B);
            if (which < 2) {
                const float* W = P.in[which == 0 ? 6 : 7] + (size_t)l * D * DFF;
                const int kb = q / 44, nb = q % 44, n0 = nb * 64;
                transpose_item(W, D, DFF, DFF, base, kb * 64, n0, (n0 >> 7) * 256 + which * 128 + (n0 & 127), scr, lane);
            } else {
                const float* W = P.in[8] + (size_t)l * DFF * D;
                const int kb = q / 16, nb = q % 16;
                transpose_item(W, DFF, D, D, (bf16*)((unsigned char*)base + FFN_UP_B), kb * 64, nb * 64, nb * 64, scr, lane);
            }
            continue;
        }
        r -= N_FFN;
        if (r < 2 * I_MLI) { const int j = r / I_MLI, q = r % I_MLI, kb = q / 48, nb = q % 48;
            transpose_item(P.in[9] + (size_t)j * D * ML_LD, D, ML_LD, ML_LD, (bf16*)(ws + WS_W_ML_IN + j * ML_IN_B), kb * 64, nb * 64, nb * 64, scr, lane); continue; }
        r -= 2 * I_MLI;
        if (r < 2 * I_MLO) { const int j = r / I_MLO, q = r % I_MLO, kb = q / 16, nb = q % 16;
            transpose_item(P.in[12] + (size_t)j * D * D, D, D, D, (bf16*)(ws + WS_W_ML_OUT + j * ML_OUT_B), kb * 64, nb * 64, nb * 64, scr, lane); continue; }
        r -= 2 * I_MLO;
        if (r < 2 * I_MBI) { const int j = r / I_MBI, q = r % I_MBI, kb = q / 84, nb = q % 84;
            transpose_item(P.in[13] + (size_t)j * D * MB_SRC, D, MB_SRC, MB_SRC, (bf16*)(ws + WS_W_MB_IN + j * MB_IN_B), kb * 64, nb * 64, nb * 64, scr, lane); continue; }
        r -= 2 * I_MBI;
        { const int j = r / I_MBO, q = r % I_MBO, kb = q / 16, nb = q % 16;
            transpose_item(P.in[20] + (size_t)j * MB_DI * D, MB_DI, D, D, (bf16*)(ws + WS_W_MB_OUT + j * MB_OUT_B), kb * 64, nb * 64, nb * 64, scr, lane); }
    }
}

__device__ __forceinline__ void norm_pass(LAS unsigned char* lds, const float* xin, float* xout, const float* y,
                                          const float* gate, const float* gpost, float wprev,
                                          const float* gpre, const float* scale, const float* shift, bf16* hm,
                                          const float* wg, const float* bg, float* gates) {
    const int tid = tid_opaque(), lane = tid & 63, wid = tid >> 6;
    LAS float* LW = (LAS float*)lds;
    if (wg) {
        for (int idx = tid; idx < 8192; idx += 512) { const int k = idx >> 3, c = idx & 7; LW[c * 1024 + k] = wg[(size_t)k * ML_LD + c]; }
        __syncthreads();
    }
    const int gw = blockIdx.x * 8 + wid, NGW = gridDim.x * 8;
#pragma nounroll
    for (int r = gw; r < S; r += NGW) {
        f32x4 xv[4];
        const float* xr = xin + (size_t)r * D + 4 * lane;
#pragma unroll
        for (int j = 0; j < 4; ++j) xv[j] = *(const f32x4*)(xr + 256 * j);
        if (y) {
            f32x4 yv[4]; const float* yr = y + (size_t)r * D + 4 * lane; float ss = 0.f;
#pragma unroll
            for (int j = 0; j < 4; ++j) { yv[j] = *(const f32x4*)(yr + 256 * j); ss += (yv[j].x * yv[j].x + yv[j].y * yv[j].y) + (yv[j].z * yv[j].z + yv[j].w * yv[j].w); }
            const float ry = rsqrtf(wave_sum(ss) * (1.0f / D) + EPS);
            float* xo = xout + (size_t)r * D + 4 * lane;
#pragma unroll
            for (int j = 0; j < 4; ++j) { const int col = 4 * lane + 256 * j; const f32x4 ga = *(const f32x4*)(gate + col), gb = *(const f32x4*)(gpost + col); xv[j] += ga * gb * (wprev * ry) * yv[j]; *(f32x4*)(xo + 256 * j) = xv[j]; }
        }
        if (hm) {
            float ss = 0.f;
#pragma unroll
            for (int j = 0; j < 4; ++j) ss += (xv[j].x * xv[j].x + xv[j].y * xv[j].y) + (xv[j].z * xv[j].z + xv[j].w * xv[j].w);
            const float rx = rsqrtf(wave_sum(ss) * (1.0f / D) + EPS);
            bf16* ho = hm + (size_t)r * D + 4 * lane;
#pragma unroll
            for (int j = 0; j < 4; ++j) { const int col = 4 * lane + 256 * j; const f32x4 pa = *(const f32x4*)(gpre + col), pb = *(const f32x4*)(scale + col), pc = *(const f32x4*)(shift + col); xv[j] = xv[j] * rx * (pa * (pb + 1.0f)) + pc; u32x2 w; w.x = pk2(xv[j].x, xv[j].y); w.y = pk2(xv[j].z, xv[j].w); *(u32x2*)(ho + 256 * j) = w; }
            if (wg) {
                float p[8];
#pragma unroll
                for (int c = 0; c < 8; ++c) { float a = 0.f;
#pragma unroll
                    for (int j = 0; j < 4; ++j) { const f32x4 w = *(const LAS f32x4*)(LW + c * 1024 + 4 * lane + 256 * j); a += (xv[j].x * w.x + xv[j].y * w.y) + (xv[j].z * w.z + xv[j].w * w.w); }
                    p[c] = wave_sum(a); }
                if (lane < 8) {
                    float v = p[0];
#pragma unroll
                    for (int c = 1; c < 8; ++c) v = (lane == c) ? p[c] : v;
                    v += bg[lane];
                    if (lane >= 4) v = fminf(v, 0.f) - log1pf(__expf(-fabsf(v)));
                    gates[(size_t)r * 8 + lane] = v;
                }
            }
        }
    }
}

__device__ __forceinline__ void ml_phase1(LAS unsigned char* lds, const bf16* proj, const float* gates, bf16* ST, float* G_arr, float* A_arr, float* NU) {
    const int tid = tid_opaque(), lane = tid & 63, wid = __builtin_amdgcn_readfirstlane(tid >> 6);
    LAS unsigned char* KT = lds; LAS unsigned char* VT = lds + 17408; LAS float* WV = (LAS float*)(lds + 51200);
#pragma nounroll
    for (int item = blockIdx.x; item < 1024; item += gridDim.x) {
        const int c = item >> 2, h = item & 3, t0 = c * 64;
        if (wid == 0) {
            const float ig = gates[(size_t)(t0 + lane) * 8 + h], lf = gates[(size_t)(t0 + lane) * 8 + 4 + h];
            const float b = scan_add(lf, lane); const float g = __shfl(b, 63);
            const float val = g - b + ig; const float a = wave_max(val);
            WV[lane] = __expf(val - a);
            if (lane == 0) { G_arr[item] = g; A_arr[item] = a; }
        }
        __syncthreads();
        {
            const int s = tid >> 3, seg = tid & 7;
            const float sc = WV[s] * 0.08838834764831845f;
            const bf16* src = proj + (size_t)(t0 + s) * ML_N + 512 + h * 128 + seg * 16;
#pragma unroll
            for (int q = 0; q < 2; ++q) { const u32x4 raw = *(const u32x4*)(src + 8 * q); u32x4 o;
                o.x = pk2(bflo(raw.x) * sc, bfhi(raw.x) * sc); o.y = pk2(bflo(raw.y) * sc, bfhi(raw.y) * sc); o.z = pk2(bflo(raw.z) * sc, bfhi(raw.z) * sc); o.w = pk2(bflo(raw.w) * sc, bfhi(raw.w) * sc);
                *(LAS u32x4*)(KT + s * 272 + seg * 32 + q * 16) = o; }
            const bf16* sv = proj + (size_t)(t0 + s) * ML_N + 1024 + h * 256 + seg * 32;
#pragma unroll
            for (int q = 0; q < 4; ++q) *(LAS u32x4*)(VT + s * 528 + seg * 64 + q * 16) = *(const u32x4*)(sv + 8 * q);
        }
        __syncthreads();
        if (tid < 128) { float sum = 0.f;
#pragma unroll 8
            for (int s = 0; s < 64; ++s) sum += bf2f(*(const LAS unsigned short*)(KT + s * 272 + tid * 2));
            NU[(size_t)item * 128 + tid] = sum; }
        f32x4 acc[2][8];
#pragma unroll
        for (int mi = 0; mi < 2; ++mi)
#pragma unroll
            for (int nb = 0; nb < 8; ++nb) acc[mi][nb] = (f32x4){0.f, 0.f, 0.f, 0.f};
#pragma unroll
        for (int ks = 0; ks < 2; ++ks) {
            bf16x8 af[2];
#pragma unroll
            for (int mi = 0; mi < 2; ++mi) af[mi] = frag_tr(VT, 528, 32 * ks, 32 * wid + 16 * mi, lane);
#pragma unroll
            for (int nb = 0; nb < 8; ++nb) { const bf16x8 bfr = frag_tr(KT, 272, 32 * ks, 16 * nb, lane);
#pragma unroll
                for (int mi = 0; mi < 2; ++mi) acc[mi][nb] = MFMA16(bfr, af[mi], acc[mi][nb]); }
        }
        bf16* dst = ST + (size_t)item * 32768;
#pragma unroll
        for (int mi = 0; mi < 2; ++mi)
#pragma unroll
            for (int nb = 0; nb < 8; ++nb) { const int v = 32 * wid + 16 * mi + (lane & 15), d = 16 * nb + 4 * (lane >> 4);
                u32x2 w; w.x = pk2(acc[mi][nb].x, acc[mi][nb].y); w.y = pk2(acc[mi][nb].z, acc[mi][nb].w); *(u32x2*)(dst + v * 128 + d) = w; }
        __syncthreads();
    }
}

__device__ __forceinline__ void ml_phase2(bf16* ST, const float* G_arr, const float* A_arr, float* M_arr, float* NU) {
    for (int e = blockIdx.x * 512 + tid_opaque(); e < 131072; e += gridDim.x * 512) {
        const int h = e >> 15, idx = e & 32767;
        const bool do_n = idx < 128;
        float m = 0.f, st = 0.f, nst = 0.f;
        for (int c0 = 0; c0 < 256; c0 += 8) {
            unsigned short u[8]; float nu[8];
#pragma unroll
            for (int j = 0; j < 8; ++j) { u[j] = ST[(size_t)((c0 + j) * 4 + h) * 32768 + idx]; nu[j] = do_n ? NU[(size_t)((c0 + j) * 4 + h) * 128 + idx] : 0.f; }
#pragma unroll
            for (int j = 0; j < 8; ++j) {
                const int ci = (c0 + j) * 4 + h;
                const float g = G_arr[ci], a = A_arr[ci];
                if (idx == 0) M_arr[ci] = m;
                ST[(size_t)ci * 32768 + idx] = (unsigned short)f2bf(st);
                if (do_n) NU[(size_t)ci * 128 + idx] = nst;
                const float mn = fmaxf(g + m, a), dec = __expf(g + m - mn), add = __expf(a - mn);
                st = dec * st + add * bf2f(u[j]); nst = dec * nst + add * nu[j]; m = mn;
            }
        }
    }
}

__device__ __forceinline__ void ml_phase3(LAS unsigned char* lds, const bf16* proj, const float* gates, const bf16* ST, const float* M_arr, const float* NS,
                                          const float* normw, bf16* HS) {
    const int tid = tid_opaque(), lane = tid & 63, wid = __builtin_amdgcn_readfirstlane(tid >> 6);
    const int li = lane & 15, lg = lane >> 4;
    LAS unsigned char* Q = lds; LAS unsigned char* K = lds + 17408; LAS unsigned char* V = lds + 34816; LAS unsigned char* SM = lds + 68608;
    LAS float* ROWT = (LAS float*)(lds + 77824); LAS float* COLT = ROWT + 64; LAS float* INTER = ROWT + 128; LAS float* EMT = ROWT + 192; LAS float* DEN = ROWT + 256;
    LAS float* NV = ROWT + 320;
    LAS float* SSQ = ROWT + 448;
#pragma nounroll
    for (int item = blockIdx.x; item < 1024; item += gridDim.x) {
        const int c = item >> 2, h = item & 3, t0 = c * 64;
        if (wid == 0) {
            const float ig = gates[(size_t)(t0 + lane) * 8 + h], lf = gates[(size_t)(t0 + lane) * 8 + 4 + h];
            const float b = scan_add(lf, lane);
            const float ct = ig - b; const float pm = scan_max(ct, lane);
            const float mc = M_arr[item];
            const float mt = fmaxf(b + pm, b + mc);
            ROWT[lane] = b - mt; COLT[lane] = ct; INTER[lane] = __expf(b + mc - mt); EMT[lane] = __expf(-mt);
        }
        {
            const int s = tid >> 3, seg = tid & 7;
            const bf16* rowp = proj + (size_t)(t0 + s) * ML_N;
            const bf16* sq = rowp + h * 128 + seg * 16; const bf16* sk = rowp + 512 + h * 128 + seg * 16; const bf16* sv = rowp + 1024 + h * 256 + seg * 32;
#pragma unroll
            for (int q = 0; q < 2; ++q) { *(LAS u32x4*)(Q + s * 272 + seg * 32 + q * 16) = *(const u32x4*)(sq + 8 * q); *(LAS u32x4*)(K + s * 272 + seg * 32 + q * 16) = *(const u32x4*)(sk + 8 * q); }
#pragma unroll
            for (int q = 0; q < 4; ++q) *(LAS u32x4*)(V + s * 528 + seg * 64 + q * 16) = *(const u32x4*)(sv + 8 * q);
            if (tid < 128) NV[tid] = NS[(size_t)item * 128 + tid];
        }
        __syncthreads();
        {
            const int mb = wid >> 1;
            f32x4 sa[2] = {(f32x4){0.f, 0.f, 0.f, 0.f}, (f32x4){0.f, 0.f, 0.f, 0.f}};
#pragma unroll
            for (int ks = 0; ks < 4; ++ks) { const bf16x8 af = frag_row(Q, 272, 16 * mb, 32 * ks, lane);
#pragma unroll
                for (int q = 0; q < 2; ++q) { const bf16x8 bfr = frag_row(K, 272, 16 * (2 * (wid & 1) + q), 32 * ks, lane); sa[q] = MFMA16(bfr, af, sa[q]); } }
            const int t = 16 * mb + li; const float rt = ROWT[t];
#pragma unroll
            for (int q = 0; q < 2; ++q) { const int s0 = 16 * (2 * (wid & 1) + q) + 4 * lg; float o[4];
#pragma unroll
                for (int j = 0; j < 4; ++j) { const int s = s0 + j; o[j] = (s <= t) ? sa[q][j] * 0.08838834764831845f * __expf(rt + COLT[s]) : 0.f; }
                u32x2 w; w.x = pk2(o[0], o[1]); w.y = pk2(o[2], o[3]); *(LAS u32x2*)(SM + t * 144 + s0 * 2) = w; }
        }
        __syncthreads();
        {
            const int t = tid >> 3, seg = tid & 7;
            const u32x4 sr = *(const LAS u32x4*)(SM + t * 144 + seg * 16);
            float d1 = (bflo(sr.x) + bfhi(sr.x)) + (bflo(sr.y) + bfhi(sr.y)) + (bflo(sr.z) + bfhi(sr.z)) + (bflo(sr.w) + bfhi(sr.w));
            float d2 = 0.f;
#pragma unroll
            for (int q = 0; q < 2; ++q) { const u32x4 qr = *(const LAS u32x4*)(Q + t * 272 + seg * 32 + q * 16); const LAS float* nv = NV + seg * 16 + q * 8;
                d2 += bflo(qr.x) * nv[0] + bfhi(qr.x) * nv[1] + bflo(qr.y) * nv[2] + bfhi(qr.y) * nv[3] + bflo(qr.z) * nv[4] + bfhi(qr.z) * nv[5] + bflo(qr.w) * nv[6] + bfhi(qr.w) * nv[7]; }
            float dd = d1 + INTER[t] * d2;
            dd += __shfl_xor(dd, 1); dd += __shfl_xor(dd, 2); dd += __shfl_xor(dd, 4);
            if (seg == 0) DEN[t] = dd;
        }
        f32x4 acc[4][2];
#pragma unroll
        for (int mb = 0; mb < 4; ++mb) { acc[mb][0] = (f32x4){0.f, 0.f, 0.f, 0.f}; acc[mb][1] = acc[mb][0]; }
        {
            const bf16* ct = ST + (size_t)item * 32768 + (size_t)(32 * wid + li) * 128 + 8 * lg;
#pragma unroll
            for (int ks = 0; ks < 4; ++ks) {
                bf16x8 bfr[2];
#pragma unroll
                for (int nb = 0; nb < 2; ++nb) bfr[nb] = *(const bf16x8*)(ct + nb * 16 * 128 + 32 * ks);
#pragma unroll
                for (int mb = 0; mb < 4; ++mb) { const bf16x8 af = frag_row(Q, 272, 16 * mb, 32 * ks, lane);
#pragma unroll
                    for (int nb = 0; nb < 2; ++nb) acc[mb][nb] = MFMA16(bfr[nb], af, acc[mb][nb]); }
            }
#pragma unroll
            for (int mb = 0; mb < 4; ++mb) { const float it = INTER[16 * mb + li]; acc[mb][0] *= it; acc[mb][1] *= it; }
#pragma unroll
            for (int ks = 0; ks < 2; ++ks) {
                bf16x8 bfr[2];
#pragma unroll
                for (int nb = 0; nb < 2; ++nb) bfr[nb] = frag_tr(V, 528, 32 * ks, 32 * wid + 16 * nb, lane);
#pragma unroll
                for (int mb = 0; mb < 4; ++mb) { const bf16x8 af = frag_row(SM, 144, 16 * mb, 32 * ks, lane);
#pragma unroll
                    for (int nb = 0; nb < 2; ++nb) acc[mb][nb] = MFMA16(bfr[nb], af, acc[mb][nb]); }
            }
        }
        __syncthreads();
#pragma unroll
        for (int mb = 0; mb < 4; ++mb) {
            const int t = 16 * mb + li;
            const float rd = 1.0f / fmaxf(fabsf(DEN[t]), EMT[t]);
            acc[mb][0] *= rd; acc[mb][1] *= rd;
            float q = 0.f;
#pragma unroll
            for (int nb = 0; nb < 2; ++nb) q += (acc[mb][nb].x * acc[mb][nb].x + acc[mb][nb].y * acc[mb][nb].y) + (acc[mb][nb].z * acc[mb][nb].z + acc[mb][nb].w * acc[mb][nb].w);
            q += __shfl_xor(q, 16); q += __shfl_xor(q, 32);
            if (lg == 0) SSQ[t * 8 + wid] = q;
        }
        __syncthreads();
#pragma unroll
        for (int mb = 0; mb < 4; ++mb) {
            const int t = 16 * mb + li;
            const f32x4 p0 = *(const LAS f32x4*)(SSQ + t * 8), p1 = *(const LAS f32x4*)(SSQ + t * 8 + 4);
            const float rstd = rsqrtf(((p0.x + p0.y) + (p0.z + p0.w) + (p1.x + p1.y) + (p1.z + p1.w)) * (1.0f / 256.0f) + EPS);
#pragma unroll
            for (int nb = 0; nb < 2; ++nb) {
                const int col = h * 256 + 32 * wid + 16 * nb + 4 * lg;
                const u32x2 ov = *(const u32x2*)(proj + (size_t)(t0 + t) * ML_N + 2048 + col);
                const f32x4 nw = *(const f32x4*)(normw + col);
                const f32x4 a = acc[mb][nb];
                u32x2 w; w.x = pk2(a.x * rstd * nw.x * sigmoidf_(bflo(ov.x)), a.y * rstd * nw.y * sigmoidf_(bfhi(ov.x)));
                w.y = pk2(a.z * rstd * nw.z * sigmoidf_(bflo(ov.y)), a.w * rstd * nw.w * sigmoidf_(bfhi(ov.y)));
                *(u32x2*)(HS + (size_t)(t0 + t) * D + col) = w;
            }
        }
        __syncthreads();
    }
}

__device__ __forceinline__ void conv8(const bf16* proj, const float* cw, const float* cb, int t, int j0, float (&o)[8]) {
    const f32x4 b0 = *(const f32x4*)(cb + j0), b1 = *(const f32x4*)(cb + j0 + 4);
    o[0] = b0.x; o[1] = b0.y; o[2] = b0.z; o[3] = b0.w; o[4] = b1.x; o[5] = b1.y; o[6] = b1.z; o[7] = b1.w;
#pragma unroll
    for (int tap = 0; tap < 4; ++tap) {
        const int tt = t - 3 + tap;
        if (tt >= 0) {
            const u32x4 raw = *(const u32x4*)(proj + (size_t)tt * MB_N + 2048 + j0);
            const f32x4 w0 = *(const f32x4*)(cw + tap * 3072 + j0), w1 = *(const f32x4*)(cw + tap * 3072 + j0 + 4);
            o[0] += w0.x * bflo(raw.x); o[1] += w0.y * bfhi(raw.x); o[2] += w0.z * bflo(raw.y); o[3] += w0.w * bfhi(raw.y);
            o[4] += w1.x * bflo(raw.z); o[5] += w1.y * bfhi(raw.z); o[6] += w1.z * bflo(raw.w); o[7] += w1.w * bfhi(raw.w);
        }
    }
#pragma unroll
    for (int e = 0; e < 8; ++e) o[e] = silu(o[e]);
}
__device__ __forceinline__ void conv8_store(LAS unsigned char* dst, const bf16* proj, const float* cw, const float* cb, int t, int j0, float sc) {
    float o[8]; conv8(proj, cw, cb, t, j0, o);
    u32x4 w; w.x = pk2(o[0] * sc, o[1] * sc); w.y = pk2(o[2] * sc, o[3] * sc); w.z = pk2(o[4] * sc, o[5] * sc); w.w = pk2(o[6] * sc, o[7] * sc);
    *(LAS u32x4*)dst = w;
}

__device__ __forceinline__ void mb_phase1(LAS unsigned char* lds, const bf16* proj, const float* cw, const float* cb, const float* dtb, const float* Alog,
                                          bf16* ST, float* ACUM, float* DT, float* ALAST) {
    const int tid = tid_opaque(), lane = tid & 63, wid = __builtin_amdgcn_readfirstlane(tid >> 6);
    LAS unsigned char* BC = lds; LAS unsigned char* XS = lds + 34816; LAS float* WSC = (LAS float*)(lds + 71680);
#pragma nounroll
    for (int item = blockIdx.x; item < 512; item += gridDim.x) {
        const int c = item >> 2, g = item & 3, t0 = c * 128;
        {
            const int hd = 8 * g + wid; const float A = -__expf(Alog[hd]), bias = dtb[hd];
            const int r0 = 2 * lane;
            const float dt0 = softplus_(bf2f(proj[(size_t)(t0 + r0) * MB_N + 5120 + hd]) + bias), dt1 = softplus_(bf2f(proj[(size_t)(t0 + r0 + 1) * MB_N + 5120 + hd]) + bias);
            const float da0 = dt0 * A, da1 = dt1 * A;
            const float inc = scan_add(da0 + da1, lane);
            const float a1 = inc, a0 = inc - da1, al = __shfl(inc, 63);
            ACUM[(size_t)(t0 + r0) * 32 + hd] = a0; ACUM[(size_t)(t0 + r0 + 1) * 32 + hd] = a1;
            DT[(size_t)(t0 + r0) * 32 + hd] = dt0; DT[(size_t)(t0 + r0 + 1) * 32 + hd] = dt1;
            WSC[wid * 128 + r0] = __expf(al - a0) * dt0; WSC[wid * 128 + r0 + 1] = __expf(al - a1) * dt1;
            if (lane == 63) ALAST[c * 32 + hd] = al;
        }
        {
            const int s = tid >> 2, seg = tid & 3;
#pragma unroll
            for (int q = 0; q < 4; ++q) conv8_store(BC + s * 272 + seg * 64 + q * 16, proj, cw, cb, t0 + s, 2048 + g * 128 + seg * 32 + q * 8, 1.0f);
        }
        __syncthreads();
        bf16x8 bfr[4];
#pragma unroll
        for (int ks = 0; ks < 4; ++ks) bfr[ks] = frag_tr(BC, 272, 32 * ks, 16 * wid, lane);
#pragma nounroll
        for (int hl = 0; hl < 8; ++hl) {
            LAS unsigned char* X = XS + (hl & 1) * 18432;
            const int hd = 8 * g + hl;
            {
                const int s = tid >> 2, seg = tid & 3; const float sc = WSC[hl * 128 + s];
#pragma unroll
                for (int q = 0; q < 2; ++q) conv8_store(X + s * 144 + seg * 32 + q * 16, proj, cw, cb, t0 + s, hd * 64 + seg * 16 + q * 8, sc);
            }
            __syncthreads();
            f32x4 acc[4];
#pragma unroll
            for (int mb = 0; mb < 4; ++mb) acc[mb] = (f32x4){0.f, 0.f, 0.f, 0.f};
#pragma unroll
            for (int ks = 0; ks < 4; ++ks)
#pragma unroll
                for (int mb = 0; mb < 4; ++mb) { const bf16x8 af = frag_tr(X, 144, 32 * ks, 16 * mb, lane); acc[mb] = MFMA16(bfr[ks], af, acc[mb]); }
            bf16* dst = ST + (size_t)(c * 32 + hd) * 8192;
#pragma unroll
            for (int mb = 0; mb < 4; ++mb) { const int p = 16 * mb + (lane & 15), n = 16 * wid + 4 * (lane >> 4);
                u32x2 w; w.x = pk2(acc[mb].x, acc[mb].y); w.y = pk2(acc[mb].z, acc[mb].w); *(u32x2*)(dst + p * 128 + n) = w; }
        }
        __syncthreads();
    }
}

__device__ __forceinline__ void mb_phase2(bf16* ST, const float* ALAST) {
    for (int e = blockIdx.x * 512 + tid_opaque(); e < 131072; e += gridDim.x * 512) {
        const int hd = e >> 12, idx = (e & 4095) * 2;
        float s0 = 0.f, s1 = 0.f;
        for (int c0 = 0; c0 < 128; c0 += 8) {
            unsigned u[8];
#pragma unroll
            for (int j = 0; j < 8; ++j) u[j] = *(const unsigned*)(ST + (size_t)((c0 + j) * 32 + hd) * 8192 + idx);
#pragma unroll
            for (int j = 0; j < 8; ++j) {
                const int ci = (c0 + j) * 32 + hd;
                *(unsigned*)(ST + (size_t)ci * 8192 + idx) = pk2(s0, s1);
                const float dec = __expf(ALAST[ci]);
                s0 = dec * s0 + bflo(u[j]); s1 = dec * s1 + bfhi(u[j]);
            }
        }
    }
}

__device__ __forceinline__ void mb_phase3(LAS unsigned char* lds, const bf16* proj, const float* cw, const float* cb, const float* Dsk, const float* normw,
                                          const bf16* ST, const float* ACUM, const float* DT, bf16* YO) {
    const int tid = tid_opaque(), lane = tid & 63, wid = __builtin_amdgcn_readfirstlane(tid >> 6);
    const int li = lane & 15, lg = lane >> 4;
    LAS unsigned char* CC = lds; LAS unsigned char* RB = lds + 34816; LAS unsigned char* XS = RB; LAS unsigned char* STT = RB + 18432;
    LAS unsigned char* WW = lds + 71680 + wid * 4352;
    LAS float* AA = (LAS float*)(lds + 106496); LAS float* DD = AA + 1024;
#pragma nounroll
    for (int item = blockIdx.x; item < 512; item += gridDim.x) {
        const int c = item >> 2, g = item & 3, t0 = c * 128;
        {
            const int s = tid >> 2, seg = tid & 3;
#pragma unroll
            for (int q = 0; q < 4; ++q) {
                conv8_store(CC + s * 272 + seg * 64 + q * 16, proj, cw, cb, t0 + s, 2048 + 512 + g * 128 + seg * 32 + q * 8, 1.0f);
                conv8_store(RB + s * 272 + seg * 64 + q * 16, proj, cw, cb, t0 + s, 2048 + g * 128 + seg * 32 + q * 8, 1.0f);
            }
#pragma unroll
            for (int q = 0; q < 2; ++q) { const int hl = seg * 2 + q; AA[hl * 128 + s] = ACUM[(size_t)(t0 + s) * 32 + 8 * g + hl]; DD[hl * 128 + s] = DT[(size_t)(t0 + s) * 32 + 8 * g + hl]; }
        }
        __syncthreads();
        bf16x8 cf[4];
#pragma unroll
        for (int ks = 0; ks < 4; ++ks) cf[ks] = frag_row(CC, 272, 16 * wid, 32 * ks, lane);
        f32x4 G[8];
#pragma unroll
        for (int nb = 0; nb < 8; ++nb) {
            G[nb] = (f32x4){0.f, 0.f, 0.f, 0.f};
            if (nb <= wid) {
#pragma unroll
                for (int ks = 0; ks < 4; ++ks) { const bf16x8 bfr = frag_row(RB, 272, 16 * nb, 32 * ks, lane); G[nb] = MFMA16(bfr, cf[ks], G[nb]); }
            }
        }
        __syncthreads();
        const int t = 16 * wid + li;
        float ssq = 0.f;
#pragma nounroll
        for (int hl = 0; hl < 8; ++hl) {
            const int hd = 8 * g + hl;
            {
                const int s = tid >> 2, seg = tid & 3;
#pragma unroll
                for (int q = 0; q < 2; ++q) conv8_store(XS + s * 144 + seg * 32 + q * 16, proj, cw, cb, t0 + s, hd * 64 + seg * 16 + q * 8, 1.0f);
                const int p = tid >> 3, sg = tid & 7;
                const bf16* sp = ST + (size_t)(c * 32 + hd) * 8192 + p * 128 + sg * 16;
#pragma unroll
                for (int q = 0; q < 2; ++q) *(LAS u32x4*)(STT + p * 272 + sg * 32 + q * 16) = *(const u32x4*)(sp + 8 * q);
            }
            __syncthreads();
            const float at = AA[hl * 128 + t];
            f32x4 acc[4];
#pragma unroll
            for (int nb = 0; nb < 4; ++nb) acc[nb] = (f32x4){0.f, 0.f, 0.f, 0.f};
#pragma unroll
            for (int ks = 0; ks < 4; ++ks)
#pragma unroll
                for (int nb = 0; nb < 4; ++nb) { const bf16x8 bfr = frag_row(STT, 272, 16 * nb, 32 * ks, lane); acc[nb] = MFMA16(bfr, cf[ks], acc[nb]); }
            { const float ea = __expf(at);
#pragma unroll
              for (int nb = 0; nb < 4; ++nb) acc[nb] *= ea; }
#pragma unroll
            for (int nb = 0; nb < 8; ++nb) {
                const int s0 = 16 * nb + 4 * lg; float o[4];
                const f32x4 as = *(const LAS f32x4*)(AA + hl * 128 + s0), ds = *(const LAS f32x4*)(DD + hl * 128 + s0);
#pragma unroll
                for (int j = 0; j < 4; ++j) { const int s = s0 + j; o[j] = (s <= t) ? G[nb][j] * __expf(at - as[j]) * ds[j] : 0.f; }
                u32x2 w; w.x = pk2(o[0], o[1]); w.y = pk2(o[2], o[3]); *(LAS u32x2*)(WW + li * 272 + s0 * 2) = w;
            }
            for (int ks = 0; ks <= (wid >> 1); ++ks) {
                const bf16x8 af = frag_row(WW, 272, 0, 32 * ks, lane);
#pragma unroll
                for (int nb = 0; nb < 4; ++nb) { const bf16x8 bfr = frag_tr(XS, 144, 32 * ks, 16 * nb, lane); acc[nb] = MFMA16(bfr, af, acc[nb]); }
            }
            const float dsk = Dsk[hd];
#pragma unroll
            for (int nb = 0; nb < 4; ++nb) {
                const int p0 = 16 * nb + 4 * lg;
                const u32x2 xv = *(const LAS u32x2*)(XS + t * 144 + p0 * 2);
                const u32x2 zv = *(const u32x2*)(proj + (size_t)(t0 + t) * MB_N + hd * 64 + p0);
                f32x4 yv;
                yv.x = (acc[nb].x + dsk * bflo(xv.x)) * silu(bflo(zv.x)); yv.y = (acc[nb].y + dsk * bfhi(xv.x)) * silu(bfhi(zv.x));
                yv.z = (acc[nb].z + dsk * bflo(xv.y)) * silu(bflo(zv.y)); yv.w = (acc[nb].w + dsk * bfhi(xv.y)) * silu(bfhi(zv.y));
                ssq += (yv.x * yv.x + yv.y * yv.y) + (yv.z * yv.z + yv.w * yv.w);
                u32x2 w; w.x = pk2(yv.x, yv.y); w.y = pk2(yv.z, yv.w);
                *(u32x2*)(YO + (size_t)(t0 + t) * MB_DI + hd * 64 + p0) = w;
            }
            __syncthreads();
        }
        ssq += __shfl_xor(ssq, 16); ssq += __shfl_xor(ssq, 32);
        const float rstd = rsqrtf(ssq * (1.0f / 512.0f) + EPS);
#pragma nounroll
        for (int hl = 0; hl < 8; ++hl) {
#pragma unroll
            for (int nb = 0; nb < 4; ++nb) {
                const int col = (8 * g + hl) * 64 + 16 * nb + 4 * lg;
                bf16* yp = YO + (size_t)(t0 + t) * MB_DI + col;
                const u32x2 yv = *(const u32x2*)yp; const f32x4 nw = *(const f32x4*)(normw + col);
                u32x2 w; w.x = pk2(bflo(yv.x) * rstd * nw.x, bfhi(yv.x) * rstd * nw.y); w.y = pk2(bflo(yv.y) * rstd * nw.z, bfhi(yv.y) * rstd * nw.w);
                *(u32x2*)yp = w;
            }
        }
        __syncthreads();
    }
}

template <class Epi>
__device__ __forceinline__ void run_gemm(LAS unsigned char* lds, const bf16* A, const bf16* Bt, int N, int K, const Epi& E) {
    pg8::Gemm g{A, Bt, S, N, K}; pg8::StaticOrder so; so.init(S, N, (int)gridDim.x, (int)blockIdx.x);
    pg8::gemm_phase<Epi, pg8::StaticOrder, true, true>(lds, g, so, E);
}

template <int I, int SUB>
__device__ __forceinline__ void sublayer(LAS unsigned char* lds, const Params& P, cg::grid_group& grid) {
    unsigned char* ws = P.ws;
    float* MOD = (float*)(ws + WS_MOD); float* GATES = (float*)(ws + WS_GATES);
    float* G_arr = (float*)(ws + WS_MISC + MI_G); float* A_arr = (float*)(ws + WS_MISC + MI_A); float* M_arr = (float*)(ws + WS_MISC + MI_M);
    float* NU = (float*)(ws + WS_MISC + MI_NU); float* ALAST = (float*)(ws + WS_MISC + MI_ALAST);
    float* ACUM = (float*)(ws + WS_ACUM); float* DTB = (float*)(ws + WS_DT);
    bf16* HM = (bf16*)(ws + WS_HM); bf16* PROJ = (bf16*)(ws + WS_PROJ); bf16* ST = (bf16*)(ws + WS_ST); float* Y = (float*)(ws + WS_Y);
    const float* npre = P.in[4]; const float* npost = P.in[5];
    constexpr int i = I, s = SUB, j = I >> 1; constexpr bool is_ml = (I & 1) == 0;
    const float* modi = MOD + i * 9216;
    {
        constexpr bool first = (i == 0 && s == 0);
        constexpr int pi = (s == 0) ? i - 1 : i, ps = (s == 0) ? 2 : s - 1;
        const float* pgate = first ? nullptr : MOD + pi * 9216 + (ps * 3 + 2) * 1024;
        const float* pgp = first ? nullptr : npost + (pi * 3 + ps) * 1024;
        const float* xin = (first || (i == 0 && s == 1)) ? P.in[0] : P.out;
        constexpr bool gates_on = is_ml && s == 1;
#ifndef NO_NORM
        norm_pass(lds, xin, P.out, first ? nullptr : Y, pgate, pgp, (ps == 1) ? 1.0f : 0.5f,
                  npre + (i * 3 + s) * 1024, modi + (s * 3 + 1) * 1024, modi + (s * 3 + 0) * 1024, HM,
                  gates_on ? P.in[9] + (size_t)j * D * ML_LD + 3072 : nullptr, P.in[10] + j * 8, GATES);
#endif
    }
    grid.sync();
    if constexpr (s != 1) {
        constexpr int f = (s == 0) ? 0 : 1;
        const unsigned char* wb = ws + WS_W + (size_t)(i * 2 + f) * FFN_B;
        { pg8::EpiSwiGLU E{PROJ, DFF}; run_gemm(lds, HM, (const bf16*)wb, 2 * DFF, D, E); }
        grid.sync();
        { pg8::EpiStoreF32 E{Y, D}; run_gemm(lds, PROJ, (const bf16*)(wb + FFN_UP_B), D, DFF, E); }
        grid.sync();
    } else if constexpr (is_ml) {
        { pg8::EpiStoreBf16 E{PROJ, ML_N}; run_gemm(lds, HM, (const bf16*)(ws + WS_W_ML_IN + j * ML_IN_B), ML_N, D, E); }
        grid.sync();
#ifndef NO_ML
        ml_phase1(lds, PROJ, GATES, ST, G_arr, A_arr, NU);
        grid.sync();
        ml_phase2(ST, G_arr, A_arr, M_arr, NU);
        grid.sync();
        ml_phase3(lds, PROJ, GATES, ST, M_arr, NU, P.in[11] + j * 1024, HM);
        grid.sync();
#endif
        { pg8::EpiStoreF32 E{Y, D}; run_gemm(lds, HM, (const bf16*)(ws + WS_W_ML_OUT + j * ML_OUT_B), D, D, E); }
        grid.sync();
    } else {
        { pg8::EpiStoreBf16 E{PROJ, MB_N}; run_gemm(lds, HM, (const bf16*)(ws + WS_W_MB_IN + j * MB_IN_B), MB_N, D, E); }
        grid.sync();
#ifndef NO_MB
        mb_phase1(lds, PROJ, P.in[14] + (size_t)j * 4 * 3072, P.in[15] + j * 3072, P.in[16] + j * 32, P.in[17] + j * 32, ST, ACUM, DTB, ALAST);
        grid.sync();
        mb_phase2(ST, ALAST);
        grid.sync();
        mb_phase3(lds, PROJ, P.in[14] + (size_t)j * 4 * 3072, P.in[15] + j * 3072, P.in[18] + j * 32, P.in[19] + j * 2048, ST, ACUM, DTB, HM);
        grid.sync();
#endif
        { pg8::EpiStoreF32 E{Y, D}; run_gemm(lds, HM, (const bf16*)(ws + WS_W_MB_OUT + j * MB_OUT_B), D, MB_DI, E); }
        grid.sync();
    }
}

__global__ void __launch_bounds__(512) mega_fwd(Params P) {
    extern __shared__ __attribute__((aligned(16))) unsigned char lds_raw[];
    LAS unsigned char* lds = (LAS unsigned char*)lds_raw;
    cg::grid_group grid = cg::this_grid();
#ifndef NO_PRO
    prologue(lds, P);
#endif
    grid.sync();
    sublayer<0, 0>(lds, P, grid); sublayer<0, 1>(lds, P, grid); sublayer<0, 2>(lds, P, grid);
    sublayer<1, 0>(lds, P, grid); sublayer<1, 1>(lds, P, grid); sublayer<1, 2>(lds, P, grid);
    sublayer<2, 0>(lds, P, grid); sublayer<2, 1>(lds, P, grid); sublayer<2, 2>(lds, P, grid);
    sublayer<3, 0>(lds, P, grid); sublayer<3, 1>(lds, P, grid); sublayer<3, 2>(lds, P, grid);
    {
        float* MOD = (float*)(P.ws + WS_MOD); float* Y = (float*)(P.ws + WS_Y);
        norm_pass(lds, P.out, P.out, Y, MOD + 3 * 9216 + (2 * 3 + 2) * 1024, P.in[5] + (3 * 3 + 2) * 1024, 0.5f,
                  nullptr, nullptr, nullptr, nullptr, nullptr, nullptr, nullptr);
    }
}

extern "C" void kernel_launch(void* const* d_in, const int* in_sizes, int n_in, void* d_out, int out_size, void* d_ws, size_t ws_size, hipStream_t stream) {
    static int grid_blocks = 0;
    if (grid_blocks == 0) {
        if (n_in != 21 || ws_size < WS_END) { fprintf(stderr, "kernel_launch: unexpected n_in %d / ws_size %zu (need %zu)\n", n_in, ws_size, (size_t)WS_END); grid_blocks = -1; return; }
        int dev = 0, cus = 0, per_cu = 0;
        hipGetDevice(&dev);
        hipDeviceGetAttribute(&cus, hipDeviceAttributeMultiprocessorCount, dev);
        hipFuncSetAttribute((const void*)mega_fwd, hipFuncAttributeMaxDynamicSharedMemorySize, LDS_BYTES);
        hipOccupancyMaxActiveBlocksPerMultiprocessor(&per_cu, (const void*)mega_fwd, 512, LDS_BYTES);
        if (per_cu < 1) per_cu = 1;
        grid_blocks = cus * per_cu;
        (void)hipGetLastError();
    }
    if (grid_blocks < 0) return;
    Params p{};
    for (int i = 0; i < 21; ++i) p.in[i] = (const float*)d_in[i];
    p.out = (float*)d_out; p.ws = (unsigned char*)d_ws;
    void* args[] = {&p};
    hipError_t e = hipLaunchCooperativeKernel((const void*)mega_fwd, dim3(grid_blocks), dim3(512), args, LDS_BYTES, stream);
    if (e != hipSuccess) fprintf(stderr, "cooperative launch failed: %s (grid %d)\n", hipGetErrorString(e), grid_blocks);
}
```

```cpp
#include <hip/hip_runtime.h>
#include <hip/hip_cooperative_groups.h>
#include <cstdio>
#include <cstdint>
namespace cg = cooperative_groups;
__device__ __forceinline__ int tid_opaque() { int t = threadIdx.x; asm volatile("" : "+v"(t)); return t; }
namespace pg8 {
#define PG8_LAS __attribute__((address_space(3)))
typedef unsigned short bf16_t;
typedef short bf16x8 __attribute__((ext_vector_type(8)));
typedef float f32x4 __attribute__((ext_vector_type(4)));
typedef unsigned u32x4 __attribute__((ext_vector_type(4)));
constexpr int BM = 256, BK = 64, HALF = 128, HTB = HALF * BK * 2  , STAGE_BYTES = 8 * HTB, NXCD = 8, WGM = 8;

__host__ __device__ __forceinline__ int lds_byte(int r, int c) { const int st = (r >> 4) * 2 + (c >> 5), rr = r & 15, cc = c & 31, ob = rr * 64 + cc * 2; return st * 1024 + (ob ^ (((ob >> 9) & 1) << 5)); }
__host__ __device__ __forceinline__ void stage_rc(int b, int& R, int& C) { const int st = b / 1024, sb = b % 1024, swz = sb ^ (((sb >> 9) & 1) << 5); R = (st >> 1) * 16 + swz / 64; C = (st & 1) * 32 + (swz % 64) / 2; }
__host__ __device__ __forceinline__ int perm32(int rho) { const int n = rho >> 4, i = rho & 15; return 8 * (i >> 2) + 4 * n + (i & 3); }

struct Unit { int pm, pn; };
struct Gemm { const bf16_t* A; const bf16_t* Bt; int M, N, K; };

struct StaticOrder {
    int nM, nN, nwg, G, c;
    __host__ __device__ void init(int M, int N, int G_, int c_) { nM = M / BM; nN = N / BM; nwg = nM * nN; G = G_; c = c_; }
    __host__ __device__ bool next(int i, Unit& u) const {
        const long L = (long)i * G + c; if (L >= nwg) return false;
        int wgid = (int)L; { const int q = nwg / NXCD, r = nwg % NXCD, xcd = wgid % NXCD, off = wgid / NXCD; wgid = (xcd < r ? xcd * (q + 1) : r * (q + 1) + (xcd - r) * q) + off; }
        const int nig = WGM * nN, gid = wgid / nig, fm = gid * WGM, gsz = (nM - fm) < WGM ? (nM - fm) : WGM;
        u.pm = fm + ((wgid % nig) % gsz); u.pn = (wgid % nig) / gsz; return true;
    }
    __device__ __forceinline__ void a_ready(const Unit&) const {}
    __device__ __forceinline__ void done(const Unit&) const {}
};

typedef __bf16 bf16v2_t __attribute__((ext_vector_type(2))); typedef float f32v2_t __attribute__((ext_vector_type(2)));
__device__ __forceinline__ unsigned cvt_pk_bf16(float lo, float hi) { f32v2_t v = {lo, hi}; bf16v2_t b = __builtin_convertvector(v, bf16v2_t); return __builtin_bit_cast(unsigned, b); }
typedef float f32x2 __attribute__((ext_vector_type(2)));
__device__ __forceinline__ float silu_f(float x) { return x * __builtin_amdgcn_rcpf(1.0f + __builtin_amdgcn_exp2f(-1.4426950408889634f * x)); }
struct EpiStoreBf16 {
    static constexpr bool PERM = true, AFTER_DRAIN = false;
    bf16_t* O; int ldc;
    __device__ __forceinline__ void operator()(const f32x4 (&acc)[2][2][4][2], const Unit& u, int wr, int wc, int fr, int fq) const {
        const int row0 = u.pm * BM + wr * 64 + fr; const int col0 = u.pn * BM + wc * 32 + 8 * fq;
#pragma unroll
        for (int ai = 0; ai < 2; ++ai)
#pragma unroll
            for (int m = 0; m < 4; ++m) { bf16_t* rowp = O + (size_t)(row0 + ai * HALF + m * 16) * ldc + col0;
#pragma unroll
                for (int bj = 0; bj < 2; ++bj) { const f32x4 v0 = acc[ai][bj][m][0], v1 = acc[ai][bj][m][1];
                    u32x4 w; w.x = cvt_pk_bf16(v0[0], v0[1]); w.y = cvt_pk_bf16(v0[2], v0[3]); w.z = cvt_pk_bf16(v1[0], v1[1]); w.w = cvt_pk_bf16(v1[2], v1[3]);
                    *(u32x4*)(rowp + bj * HALF) = w; } }
    }
};
struct EpiSwiGLU {
    static constexpr bool PERM = true, AFTER_DRAIN = false;
    bf16_t* O; int ldc;
    __device__ __forceinline__ void operator()(const f32x4 (&acc)[2][2][4][2], const Unit& u, int wr, int wc, int fr, int fq) const {
        const int row0 = u.pm * BM + wr * 64 + fr; const int col0 = u.pn * HALF + wc * 32 + 8 * fq;
#pragma unroll
        for (int ai = 0; ai < 2; ++ai)
#pragma unroll
            for (int m = 0; m < 4; ++m) { bf16_t* rowp = O + (size_t)(row0 + ai * HALF + m * 16) * ldc + col0;
                const f32x4 a0 = acc[ai][0][m][0], a1 = acc[ai][0][m][1], b0 = acc[ai][1][m][0], b1 = acc[ai][1][m][1];
                u32x4 w; w.x = cvt_pk_bf16(silu_f(a0[0]) * b0[0], silu_f(a0[1]) * b0[1]); w.y = cvt_pk_bf16(silu_f(a0[2]) * b0[2], silu_f(a0[3]) * b0[3]);
                w.z = cvt_pk_bf16(silu_f(a1[0]) * b1[0], silu_f(a1[1]) * b1[1]); w.w = cvt_pk_bf16(silu_f(a1[2]) * b1[2], silu_f(a1[3]) * b1[3]);
                *(u32x4*)rowp = w; }
    }
};
struct EpiStoreF32 {
    static constexpr bool PERM = false, AFTER_DRAIN = false;
    float* Y; int ldc;
    __device__ __forceinline__ void operator()(const f32x4 (&acc)[2][2][4][2], const Unit& u, int wr, int wc, int fr, int fq) const {
        const int row0 = u.pm * BM + wr * 64 + fr; const int col0 = u.pn * BM + wc * 32 + 4 * fq;
#pragma unroll
        for (int ai = 0; ai < 2; ++ai)
#pragma unroll
            for (int m = 0; m < 4; ++m) { float* rowp = Y + (size_t)(row0 + ai * HALF + m * 16) * ldc + col0;
#pragma unroll
                for (int bj = 0; bj < 2; ++bj)
#pragma unroll
                    for (int n = 0; n < 2; ++n) *(f32x4*)(rowp + bj * HALF + n * 16) = acc[ai][bj][m][n]; }
    }
};
template <class Epi, class Sched, bool ALIGN_EPI = false, bool SP2 = false>
__device__ __forceinline__ void gemm_phase(PG8_LAS unsigned char* lds, const Gemm g, const Sched& S, const Epi& E) {
    const int tid = tid_opaque(), wid = __builtin_amdgcn_readfirstlane(tid >> 6), lane = tid & 63, wr = wid >> 2, wc = wid & 3, fr = lane & 15, fq = lane >> 4;
    const int K = g.K, nt = K / BK;
    unsigned voffA[2], voffB[2];
#pragma unroll
    for (int i = 0; i < 2; ++i) { int R, C; stage_rc(tid * 16 + i * 8192, R, C); const int Rb = Epi::PERM ? ((R & ~31) + perm32(R & 31)) : R;
        voffA[i] = (unsigned)(R * K + C) * 2u; voffB[i] = (unsigned)(Rb * K + C) * 2u; }
    const size_t kstep = (size_t)(BK * 2);
    const size_t hstep = (size_t)HALF * K * 2;
    const size_t tstep = 2 * hstep;
    const unsigned ldsw = (unsigned)wid * 1024u;
    const int aoff = lds_byte(wr * 64 + fr, fq * 8), boff = lds_byte(wc * 32 + fr, fq * 8);
#define PG8_SA(b, h) (((b) * 2 + (h)) * HTB)
#define PG8_SB(b, h) ((4 + (b) * 2 + (h)) * HTB)
#define PG8_STAGE(bufoff, gbase, voff) do { _Pragma("unroll") for (int _i = 0; _i < 2; ++_i) \
        __builtin_amdgcn_global_load_lds((const unsigned*)((const char*)(gbase) + (voff)[_i]), (PG8_LAS unsigned*)(lds + (bufoff) + ldsw + _i * 8192), 16, 0, 0); } while (0)
#define PG8_LDA(dst, b, h) do { _Pragma("unroll") for (int m = 0; m < 4; ++m) _Pragma("unroll") for (int k = 0; k < 2; ++k) dst[m][k] = *(const PG8_LAS bf16x8*)(lds + PG8_SA(b, h) + aoff + m * 2048 + k * 1024); } while (0)
#define PG8_LDB(dst, b, h) do { _Pragma("unroll") for (int n = 0; n < 2; ++n) _Pragma("unroll") for (int k = 0; k < 2; ++k) dst[n][k] = *(const PG8_LAS bf16x8*)(lds + PG8_SB(b, h) + boff + n * 2048 + k * 1024); } while (0)
#define PG8_MMA(ai, bj, At, Bt) do { __builtin_amdgcn_s_setprio(1); _Pragma("unroll") for (int m = 0; m < 4; ++m) _Pragma("unroll") for (int n = 0; n < 2; ++n) _Pragma("unroll") for (int k = 0; k < 2; ++k) \
        acc[ai][bj][m][n] = __builtin_amdgcn_mfma_f32_16x16x32_bf16(Bt[n][k], At[m][k], acc[ai][bj][m][n], 0, 0, 0); __builtin_amdgcn_s_setprio(0); } while (0)
#define PG8_WAIT_V(n) asm volatile("s_waitcnt vmcnt(" #n ")" ::: "memory")
#define PG8_WAIT_L(n) asm volatile("s_waitcnt lgkmcnt(" #n ")" ::: "memory")
#define PG8_BAR __builtin_amdgcn_s_barrier()
#define PG8_SCHED __builtin_amdgcn_sched_barrier(0)
    Unit cur, nxt; int ui = 0;
    if (!S.next(0, cur)) return;
    f32x4 acc[2][2][4][2];
#pragma unroll
    for (int a = 0; a < 2; ++a)
#pragma unroll
        for (int b = 0; b < 2; ++b)
#pragma unroll
            for (int m = 0; m < 4; ++m)
#pragma unroll
                for (int n = 0; n < 2; ++n) acc[a][b][m][n] = (f32x4){0.f, 0.f, 0.f, 0.f};
    bf16x8 At[4][2], B0[2][2], B1[2][2];
    const char* cA = (const char*)g.A + (size_t)cur.pm * tstep; const char* cB = (const char*)g.Bt + (size_t)cur.pn * tstep;
    S.a_ready(cur);
    if constexpr (SP2) {
        PG8_STAGE(PG8_SB(0, 0), cB, voffB); PG8_STAGE(PG8_SB(0, 1), cB + hstep, voffB); PG8_STAGE(PG8_SA(0, 0), cA, voffA); PG8_STAGE(PG8_SA(0, 1), cA + hstep, voffA);
        if (wr == 1) PG8_BAR;
        PG8_WAIT_V(2); PG8_BAR;
        PG8_STAGE(PG8_SB(1, 0), cB + kstep, voffB); PG8_STAGE(PG8_SA(1, 0), cA + kstep, voffA); PG8_STAGE(PG8_SB(1, 1), cB + hstep + kstep, voffB);
        PG8_WAIT_V(6); PG8_BAR;
    } else {
        PG8_STAGE(PG8_SB(0, 0), cB, voffB); PG8_STAGE(PG8_SA(0, 0), cA, voffA); PG8_STAGE(PG8_SB(0, 1), cB + hstep, voffB); PG8_STAGE(PG8_SA(0, 1), cA + hstep, voffA);
        if (wr == 1) PG8_BAR;
        PG8_WAIT_V(4); PG8_BAR;
        PG8_STAGE(PG8_SB(1, 0), cB + kstep, voffB); PG8_STAGE(PG8_SA(1, 0), cA + kstep, voffA); PG8_STAGE(PG8_SB(1, 1), cB + hstep + kstep, voffB);
        PG8_WAIT_V(6); PG8_BAR;
    }
    for (;;) {
        const bool has_next = S.next(ui + 1, nxt);
        const char* nA = has_next ? (const char*)g.A + (size_t)nxt.pm * tstep : cA; const char* nB = has_next ? (const char*)g.Bt + (size_t)nxt.pn * tstep : cB;
        for (int t = 0; t < nt; t += 2) {
            const bool last = (t == nt - 2);
            const char* a1 = cA + (size_t)(t + 1) * kstep;
            const char* a2 = last ? nA : cA + (size_t)(t + 2) * kstep; const char* b2 = last ? nB : cB + (size_t)(t + 2) * kstep;
            const char* a3 = a2 + kstep; const char* b3 = b2 + kstep;
            if (last && has_next) S.a_ready(nxt);
            if constexpr (SP2) {
            PG8_LDB(B0, 0, 0); PG8_LDB(B1, 0, 1); PG8_SCHED; PG8_LDA(At, 0, 0); PG8_STAGE(PG8_SA(1, 1), a1 + hstep, voffA);
            PG8_WAIT_V(8); PG8_WAIT_L(0); PG8_BAR; PG8_MMA(0, 0, At, B0); PG8_MMA(0, 1, At, B1); PG8_BAR; PG8_SCHED;
            PG8_LDA(At, 0, 1); PG8_STAGE(PG8_SB(0, 0), b2, voffB); PG8_STAGE(PG8_SB(0, 1), b2 + hstep, voffB); PG8_STAGE(PG8_SA(0, 0), a2, voffA);
            PG8_WAIT_V(8); PG8_WAIT_L(0); PG8_BAR; PG8_MMA(1, 0, At, B0); PG8_MMA(1, 1, At, B1); PG8_BAR; PG8_SCHED;
            PG8_LDB(B0, 1, 0); PG8_LDB(B1, 1, 1); PG8_SCHED; PG8_LDA(At, 1, 0); PG8_STAGE(PG8_SA(0, 1), a2 + hstep, voffA);
            PG8_WAIT_V(8); PG8_WAIT_L(0); PG8_BAR; PG8_MMA(0, 0, At, B0); PG8_MMA(0, 1, At, B1); PG8_BAR; PG8_SCHED;
            PG8_LDA(At, 1, 1); PG8_STAGE(PG8_SB(1, 0), b3, voffB); PG8_STAGE(PG8_SB(1, 1), b3 + hstep, voffB); PG8_STAGE(PG8_SA(1, 0), a3, voffA);
            PG8_WAIT_V(8); PG8_WAIT_L(0); PG8_BAR; PG8_MMA(1, 0, At, B0); PG8_MMA(1, 1, At, B1); PG8_BAR; PG8_SCHED;
            } else {
            PG8_LDB(B0, 0, 0); PG8_SCHED; PG8_LDA(At, 0, 0); PG8_STAGE(PG8_SA(1, 1), a1 + hstep, voffA);
            PG8_WAIT_L(8); PG8_BAR; PG8_WAIT_L(0); PG8_MMA(0, 0, At, B0); PG8_BAR; PG8_SCHED;
            PG8_LDB(B1, 0, 1); PG8_STAGE(PG8_SB(0, 0), b2, voffB);
            PG8_BAR; PG8_WAIT_L(0); PG8_MMA(0, 1, At, B1); PG8_BAR;
            PG8_LDA(At, 0, 1); PG8_STAGE(PG8_SA(0, 0), a2, voffA);
            PG8_BAR; PG8_WAIT_L(0); PG8_MMA(1, 0, At, B0); PG8_BAR; PG8_SCHED;
            PG8_STAGE(PG8_SB(0, 1), b2 + hstep, voffB);
            PG8_WAIT_V(6); PG8_BAR; PG8_MMA(1, 1, At, B1); PG8_BAR;
            PG8_LDB(B0, 1, 0); PG8_SCHED; PG8_LDA(At, 1, 0); PG8_STAGE(PG8_SA(0, 1), a2 + hstep, voffA);
            PG8_WAIT_L(8); PG8_BAR; PG8_WAIT_L(0); PG8_MMA(0, 0, At, B0); PG8_BAR; PG8_SCHED;
            PG8_LDB(B1, 1, 1); PG8_STAGE(PG8_SB(1, 0), b3, voffB);
            PG8_BAR; PG8_WAIT_L(0); PG8_MMA(0, 1, At, B1); PG8_BAR;
            PG8_LDA(At, 1, 1); PG8_STAGE(PG8_SA(1, 0), a3, voffA);
            PG8_BAR; PG8_WAIT_L(0); PG8_MMA(1, 0, At, B0); PG8_BAR; PG8_SCHED;
            PG8_STAGE(PG8_SB(1, 1), b3 + hstep, voffB);
            PG8_WAIT_V(6); PG8_BAR; PG8_MMA(1, 1, At, B1); PG8_BAR;
            }
        }
        if constexpr (ALIGN_EPI) { if (wr == 0) PG8_BAR; }
        if constexpr (!Epi::AFTER_DRAIN) { E(acc, cur, wr, wc, fr, fq); S.done(cur); }
        if (!has_next) break;
#pragma unroll
        for (int a = 0; a < 2; ++a)
#pragma unroll
            for (int b = 0; b < 2; ++b)
#pragma unroll
                for (int m = 0; m < 4; ++m)
#pragma unroll
                    for (int n = 0; n < 2; ++n) acc[a][b][m][n] = (f32x4){0.f, 0.f, 0.f, 0.f};
        cur = nxt; cA = nA; cB = nB; ++ui;
        if constexpr (ALIGN_EPI) { if (wr == 1) PG8_BAR; }
    }
    PG8_WAIT_V(0);
    if constexpr (!ALIGN_EPI) { if (wr == 0) PG8_BAR; }
    PG8_BAR;
    if constexpr (Epi::AFTER_DRAIN) { E.fused(acc, cur, wr, wc, fr, fq, lds, wid, lane); S.done(cur); }
#undef PG8_SA
#undef PG8_SB
#undef PG8_STAGE
#undef PG8_LDA
#undef PG8_LDB
#undef PG8_MMA
#undef PG8_WAIT_V
#undef PG8_WAIT_L
#undef PG8_BAR
#undef PG8_SCHED
}
}

#define LAS __attribute__((address_space(3)))
typedef unsigned short bf16;
typedef short bf16x8 __attribute__((ext_vector_type(8)));
typedef float f32x4 __attribute__((ext_vector_type(4)));
typedef unsigned u32x4 __attribute__((ext_vector_type(4)));
typedef unsigned u32x2 __attribute__((ext_vector_type(2)));

constexpr int S = 16384, D = 1024, DFF = 2816;
constexpr int ML_N = 3072, ML_LD = 3080;
constexpr int MB_N = 5376, MB_SRC = 5152, MB_DI = 2048;
constexpr float EPS = 1e-6f;
constexpr size_t MiB = (size_t)1 << 20;
constexpr size_t WS_MOD = 0;
constexpr size_t WS_GATES = 1 * MiB;
constexpr size_t WS_MISC = 2 * MiB;
constexpr size_t WS_ACUM = 4 * MiB;
constexpr size_t WS_DT = 6 * MiB;
constexpr size_t WS_W = 8 * MiB;
constexpr size_t FFN_UP_B = (size_t)2 * DFF * D * 2, FFN_DN_B = (size_t)D * DFF * 2, FFN_B = FFN_UP_B + FFN_DN_B;
constexpr size_t ML_IN_B = (size_t)ML_N * D * 2, ML_OUT_B = (size_t)D * D * 2, MB_IN_B = (size_t)MB_N * D * 2, MB_OUT_B = (size_t)D * MB_DI * 2;
constexpr size_t WS_W_ML_IN = WS_W + 8 * FFN_B;
constexpr size_t WS_W_ML_OUT = WS_W_ML_IN + 2 * ML_IN_B;
constexpr size_t WS_W_MB_IN = WS_W_ML_OUT + 2 * ML_OUT_B;
constexpr size_t WS_W_MB_OUT = WS_W_MB_IN + 2 * MB_IN_B;
constexpr size_t WS_W_END = WS_W_MB_OUT + 2 * MB_OUT_B;
constexpr size_t WS_HM = 186 * MiB;
constexpr size_t WS_PROJ = 250 * MiB;
constexpr size_t WS_ST = 418 * MiB;
constexpr size_t WS_Y = 482 * MiB;
constexpr size_t WS_END = 546 * MiB;
static_assert(WS_W_END <= WS_HM, "ws map");
constexpr size_t MI_G = 0, MI_A = 4096, MI_M = 8192, MI_NU = 65536  , MI_ALAST = 1 * MiB  ;

constexpr int LDS_BYTES = 147456;
constexpr int XB_LDS_OFF = LDS_BYTES - 64;
constexpr size_t WS_XBAR = 3 * MiB + 512 * 1024;

struct Params { const float* in[21]; float* out; unsigned char* ws; };

__device__ __forceinline__ unsigned f2bf(float f) { unsigned u = __float_as_uint(f); return (u + 0x7fffu + ((u >> 16) & 1u)) >> 16; }
__device__ __forceinline__ unsigned pk2(float lo, float hi) { return pg8::cvt_pk_bf16(lo, hi); }
__device__ __forceinline__ float bflo(unsigned w) { return __uint_as_float(w << 16); }
__device__ __forceinline__ float bfhi(unsigned w) { return __uint_as_float(w & 0xffff0000u); }
__device__ __forceinline__ float bf2f(unsigned short b) { return __uint_as_float((unsigned)b << 16); }
__device__ __forceinline__ float wave_sum(float v) {
#pragma unroll
    for (int o = 1; o < 64; o <<= 1) v += __shfl_xor(v, o);
    return v;
}
__device__ __forceinline__ float wave_max(float v) {
#pragma unroll
    for (int o = 1; o < 64; o <<= 1) v = fmaxf(v, __shfl_xor(v, o));
    return v;
}
__device__ __forceinline__ float scan_add(float v, int lane) {
#pragma unroll
    for (int o = 1; o < 64; o <<= 1) { const float t = __shfl_up(v, o); if (lane >= o) v += t; }
    return v;
}
__device__ __forceinline__ float scan_max(float v, int lane) {
#pragma unroll
    for (int o = 1; o < 64; o <<= 1) { const float t = __shfl_up(v, o); if (lane >= o) v = fmaxf(v, t); }
    return v;
}
__device__ __forceinline__ float silu(float x) { return x / (1.0f + __expf(-x)); }
__device__ __forceinline__ float sigmoidf_(float x) { return 1.0f / (1.0f + __expf(-x)); }
__device__ __forceinline__ float softplus_(float x) { return fmaxf(x, 0.f) + log1pf(__expf(-fabsf(x))); }

__device__ __forceinline__ bf16x8 frag_row(const LAS unsigned char* T, int strideB, int r0, int k0, int lane) {
    return *(const LAS bf16x8*)(T + (r0 + (lane & 15)) * strideB + (k0 + 8 * (lane >> 4)) * 2);
}
#ifndef USE_TR
#define USE_TR 1
#endif
__device__ __forceinline__ bf16x8 frag_tr(const LAS unsigned char* T, int strideB, int k0, int c0, int lane) {
#if USE_TR
    const int g = lane >> 4, i = lane & 15, q = i >> 2, p = i & 3;
    const unsigned a0 = (unsigned)(uintptr_t)(T + (k0 + 8 * g + q) * strideB + (c0 + 4 * p) * 2);
    const unsigned a1 = a0 + 4u * (unsigned)strideB;
    u32x2 lo, hi;
    asm volatile("ds_read_b64_tr_b16 %0, %2\n\tds_read_b64_tr_b16 %1, %3\n\ts_waitcnt lgkmcnt(0)" : "=&v"(lo), "=&v"(hi) : "v"(a0), "v"(a1) : "memory");
    u32x4 r; r.x = lo.x; r.y = lo.y; r.z = hi.x; r.w = hi.y;
    return __builtin_bit_cast(bf16x8, r);
#else
    bf16x8 r;
    const LAS unsigned char* p = T + (k0 + 8 * (lane >> 4)) * strideB + (c0 + (lane & 15)) * 2;
#pragma unroll
    for (int e = 0; e < 8; ++e) r[e] = *(const LAS short*)(p + e * strideB);
    return r;
#endif
}
#define MFMA16(b, a, c) __builtin_amdgcn_mfma_f32_16x16x32_bf16((b), (a), (c), 0, 0, 0)

#define XB_TMO      128
#define XB_XCNT(j)  (256  + 64 * (j))
#define XB_XSUB(j)  (1280 + 64 * (j))
#define XB_XGEN(j)  (2304 + 64 * (j))
#define XB_TOP      3328
#define XB_TOPGEN   3392
#define XCD_BAR_WORDS 3456
#define XB_SPIN_CAP (1u << 18)

__device__ __forceinline__ unsigned xb_ld(unsigned* p)              { return __hip_atomic_load(p, __ATOMIC_RELAXED, __HIP_MEMORY_SCOPE_AGENT); }
__device__ __forceinline__ unsigned xb_add(unsigned* p, unsigned v) { return __hip_atomic_fetch_add(p, v, __ATOMIC_RELAXED, __HIP_MEMORY_SCOPE_AGENT); }
__device__ __forceinline__ unsigned xb_xcc_id() { return (unsigned)__builtin_amdgcn_s_getreg((3 << 11) | 20) & 0xFu; }
#define XB_SPIN(cond, bar) do { unsigned _sp = 0; while (cond) { __builtin_amdgcn_s_sleep(1); \
    if ((++_sp & 255u) == 0u) { if (xb_ld(&(bar)[XB_TMO])) break; if (_sp > XB_SPIN_CAP) { atomicAdd(&(bar)[XB_TMO], 1u); break; } } } } while (0)

struct XcdBarrier {
    unsigned* bar; unsigned x;
    volatile LAS unsigned* st;
};

__device__ __forceinline__ XcdBarrier xcd_barrier_post(unsigned* bar, volatile LAS unsigned* st) {
    XcdBarrier b; b.bar = bar; b.x = xb_xcc_id(); b.st = st;
    if (threadIdx.x == 0) (void)xb_add(&bar[XB_XCNT(b.x)], 1u);
    return b;
}
__device__ __forceinline__ void xcd_barrier_complete(unsigned* bar, unsigned x, unsigned& nloc, unsigned& nx) {
    const unsigned G = gridDim.x * gridDim.y * gridDim.z;
    unsigned sum, cnt, mine, sp = 0u;
    for (;;) {
        sum = 0u; cnt = 0u; mine = 0u;
#pragma unroll
        for (unsigned j = 0; j < 16; ++j) { const unsigned c = xb_ld(&bar[XB_XCNT(j)]); sum += c; cnt += (c > 0u) ? 1u : 0u; mine = (j == x) ? c : mine; }
        if (sum == G) break;
        __builtin_amdgcn_s_sleep(1);
        if ((++sp & 255u) == 0u) { if (xb_ld(&bar[XB_TMO])) break; if (sp > XB_SPIN_CAP) { atomicAdd(&bar[XB_TMO], 1u); break; } }
    }
    nloc = mine > 0u ? mine : 1u; nx = cnt > 0u ? cnt : 1u;
}

__device__ __forceinline__ void xcd_barrier(const XcdBarrier& b) {
    asm volatile("s_waitcnt vmcnt(0)" ::: "memory");
    __syncthreads();
    if (threadIdx.x == 0) {
        unsigned* bar = b.bar;
        __builtin_amdgcn_s_waitcnt(0);
        unsigned nloc = b.st[0], nx = b.st[1];
        if (nloc == 0u) { xcd_barrier_complete(bar, b.x, nloc, nx); b.st[0] = nloc; b.st[1] = nx; }
        const unsigned old = xb_add(&bar[XB_XSUB(b.x)], 1u);
        const unsigned gen = old / nloc;
        if (old + 1u == (gen + 1u) * nloc) {
            __builtin_amdgcn_fence(__ATOMIC_RELEASE, "agent");
            asm volatile("s_waitcnt vmcnt(0)" ::: "memory");
            const unsigned og = xb_add(&bar[XB_TOP], 1u);
            const unsigned tg = og / nx;
            if (og + 1u == (tg + 1u) * nx) xb_add(&bar[XB_TOPGEN], 1u);
            else XB_SPIN(xb_ld(&bar[XB_TOPGEN]) == tg, bar);
            __builtin_amdgcn_fence(__ATOMIC_ACQUIRE, "agent");
            xb_add(&bar[XB_XGEN(b.x)], 1u);
            asm volatile("s_waitcnt vmcnt(0)" ::: "memory");
        } else {
            XB_SPIN(xb_ld(&bar[XB_XGEN(b.x)]) == gen, bar);
            __builtin_amdgcn_fence(__ATOMIC_ACQUIRE, "agent");
            asm volatile("s_waitcnt vmcnt(0)" ::: "memory");
        }
    }
    __syncthreads();
}

__device__ __forceinline__ void transpose_item(const float* W, int K, int Nld, int Nvalid, bf16* WT, int k0, int n0, int drow0, LAS float* scr, int lane) {
    const bool ok = (n0 + lane) < Nvalid;
    const float* src = W + (size_t)k0 * Nld + n0 + lane;
#pragma unroll 16
    for (int i = 0; i < 64; ++i) scr[i * 65 + lane] = ok ? src[(size_t)i * Nld] : 0.f;
    asm volatile("s_waitcnt lgkmcnt(0)" ::: "memory");
    const int c = lane & 7;
#pragma unroll
    for (int j = 0; j < 8; ++j) {
        const int n = (lane >> 3) + 8 * j; const LAS float* s = scr + (8 * c) * 65 + n;
        u32x4 o; o.x = pk2(s[0], s[65]); o.y = pk2(s[2 * 65], s[3 * 65]); o.z = pk2(s[4 * 65], s[5 * 65]); o.w = pk2(s[6 * 65], s[7 * 65]);
        *(u32x4*)(WT + (size_t)(drow0 + n) * K + k0 + 8 * c) = o;
    }
    asm volatile("s_waitcnt lgkmcnt(0)" ::: "memory");
}

__device__ __forceinline__ void prologue(LAS unsigned char* lds, const Params& P) {
    const int tid = tid_opaque(), lane = tid & 63, wid = tid >> 6;
    unsigned char* ws = P.ws;
    for (int item = blockIdx.x; item < 144; item += gridDim.x) {
        const int i = item / 36, col0 = (item % 36) * 256;
        const float* cvec = P.in[1]; const float* aw = P.in[2] + ((size_t)i * 1024 + wid * 128) * 9216 + col0 + 4 * lane;
        f32x4 acc = {0.f, 0.f, 0.f, 0.f};
#pragma unroll 16
        for (int k = 0; k < 128; ++k) { const float ca = silu(cvec[wid * 128 + k]); const f32x4 w = *(const f32x4*)(aw + (size_t)k * 9216); acc += ca * w; }
        LAS float* red = (LAS float*)lds;
        *(LAS f32x4*)(red + wid * 256 + 4 * lane) = acc;
        __syncthreads();
        if (tid < 256) { float s = P.in[3][i * 9216 + col0 + tid];
#pragma unroll
            for (int w = 0; w < 8; ++w) s += red[w * 256 + tid];
            ((float*)(ws + WS_MOD))[i * 9216 + col0 + tid] = s; }
        __syncthreads();
    }
    LAS float* scr = (LAS float*)(lds + wid * 16640);
    const int gw = blockIdx.x * 8 + wid, NGW = gridDim.x * 8;
    constexpr int I_FFN = 704, N_FFN = 24 * I_FFN, I_MLI = 16 * 48, I_MLO = 16 * 16, I_MBI = 16 * 84, I_MBO = 32 * 16;
    constexpr int NITEMS = N_FFN + 2 * (I_MLI + I_MLO + I_MBI + I_MBO);
    for (int it = gw; it < NITEMS; it += NGW) {
        int r = it;
        if (r < N_FFN) {
            const int job = r / I_FFN, q = r % I_FFN, l = job / 3, which = job % 3;
            bf16* base = (bf16*)(ws + WS_W + (size_t)l * FFN_B);
            if (which < 2) {
                const float* W = P.in[which == 0 ? 6 : 7] + (size_t)l * D * DFF;
                const int kb = q / 44, nb = q % 44, n0 = nb * 64;
                transpose_item(W, D, DFF, DFF, base, kb * 64, n0, (n0 >> 7) * 256 + which * 128 + (n0 & 127), scr, lane);
            } else {
                const float* W = P.in[8] + (size_t)l * DFF * D;
                const int kb = q / 16, nb = q % 16;
                transpose_item(W, DFF, D, D, (bf16*)((unsigned char*)base + FFN_UP_B), kb * 64, nb * 64, nb * 64, scr, lane);
            }
            continue;
        }
        r -= N_FFN;
        if (r < 2 * I_MLI) { const int j = r / I_MLI, q = r % I_MLI, kb = q / 48, nb = q % 48;
            transpose_item(P.in[9] + (size_t)j * D * ML_LD, D, ML_LD, ML_LD, (bf16*)(ws + WS_W_ML_IN + j * ML_IN_B), kb * 64, nb * 64, nb * 64, scr, lane); continue; }
        r -= 2 * I_MLI;
        if (r < 2 * I_MLO) { const int j = r / I_MLO, q = r % I_MLO, kb = q / 16, nb = q % 16;
            transpose_item(P.in[12] + (size_t)j * D * D, D, D, D, (bf16*)(ws + WS_W_ML_OUT + j * ML_OUT_B), kb * 64, nb * 64, nb * 64, scr, lane); continue; }
        r -= 2 * I_MLO;
        if (r < 2 * I_MBI) { const int j = r / I_MBI, q = r % I_MBI, kb = q / 84, nb = q % 84;
            transpose_item(P.in[13] + (size_t)j * D * MB_SRC, D, MB_SRC, MB_SRC, (bf16*)(ws + WS_W_MB_IN + j * MB_IN_B), kb * 64, nb * 64, nb * 64, scr, lane); continue; }
        r -= 2 * I_MBI;
        { const int j = r / I_MBO, q = r % I_MBO, kb = q / 16, nb = q % 16;
            transpose_item(P.in[20] + (size_t)j * MB_DI * D, MB_DI, D, D, (bf16*)(ws + WS_W_MB_OUT + j * MB_OUT_B), kb * 64, nb * 64, nb * 64, scr, lane); }
    }
}

__device__ __forceinline__ void norm_pass(LAS unsigned char* lds, const float* xin, float* xout, const float* y,
                                          const float* gate, const float* gpost, float wprev,
                                          const float* gpre, const float* scale, const float* shift, bf16* hm,
                                          const float* wg, const float* bg, float* gates) {
    const int tid = tid_opaque(), lane = tid & 63, wid = tid >> 6;
    LAS float* LW = (LAS float*)lds;
    if (wg) {
        for (int idx = tid; idx < 8192; idx += 512) { const int k = idx >> 3, c = idx & 7; LW[c * 1024 + k] = wg[(size_t)k * ML_LD + c]; }
        __syncthreads();
    }
    const int gw = blockIdx.x * 8 + wid, NGW = gridDim.x * 8;
#pragma nounroll
    for (int r = gw; r < S; r += NGW) {
        f32x4 xv[4];
        const float* xr = xin + (size_t)r * D + 4 * lane;
#pragma unroll
        for (int j = 0; j < 4; ++j) xv[j] = *(const f32x4*)(xr + 256 * j);
        if (y) {
            f32x4 yv[4]; const float* yr = y + (size_t)r * D + 4 * lane; float ss = 0.f;
#pragma unroll
            for (int j = 0; j < 4; ++j) { yv[j] = *(const f32x4*)(yr + 256 * j); ss += (yv[j].x * yv[j].x + yv[j].y * yv[j].y) + (yv[j].z * yv[j].z + yv[j].w * yv[j].w); }
            const float ry = rsqrtf(wave_sum(ss) * (1.0f / D) + EPS);
            float* xo = xout + (size_t)r * D + 4 * lane;
#pragma unroll
            for (int j = 0; j < 4; ++j) { const int col = 4 * lane + 256 * j; const f32x4 ga = *(const f32x4*)(gate + col), gb = *(const f32x4*)(gpost + col); xv[j] += ga * gb * (wprev * ry) * yv[j]; *(f32x4*)(xo + 256 * j) = xv[j]; }
        }
        if (hm) {
            float ss = 0.f;
#pragma unroll
            for (int j = 0; j < 4; ++j) ss += (xv[j].x * xv[j].x + xv[j].y * xv[j].y) + (xv[j].z * xv[j].z + xv[j].w * xv[j].w);
            const float rx = rsqrtf(wave_sum(ss) * (1.0f / D) + EPS);
            bf16* ho = hm + (size_t)r * D + 4 * lane;
#pragma unroll
            for (int j = 0; j < 4; ++j) { const int col = 4 * lane + 256 * j; const f32x4 pa = *(const f32x4*)(gpre + col), pb = *(const f32x4*)(scale + col), pc = *(const f32x4*)(shift + col); xv[j] = xv[j] * rx * (pa * (pb + 1.0f)) + pc; u32x2 w; w.x = pk2(xv[j].x, xv[j].y); w.y = pk2(xv[j].z, xv[j].w); *(u32x2*)(ho + 256 * j) = w; }
            if (wg) {
                float p[8];
#pragma unroll
                for (int c = 0; c < 8; ++c) { float a = 0.f;
#pragma unroll
                    for (int j = 0; j < 4; ++j) { const f32x4 w = *(const LAS f32x4*)(LW + c * 1024 + 4 * lane + 256 * j); a += (xv[j].x * w.x + xv[j].y * w.y) + (xv[j].z * w.z + xv[j].w * w.w); }
                    p[c] = wave_sum(a); }
                if (lane < 8) {
                    float v = p[0];
#pragma unroll
                    for (int c = 1; c < 8; ++c) v = (lane == c) ? p[c] : v;
                    v += bg[lane];
                    if (lane >= 4) v = fminf(v, 0.f) - log1pf(__expf(-fabsf(v)));
                    gates[(size_t)r * 8 + lane] = v;
                }
            }
        }
    }
}

__device__ __forceinline__ void ml_phase1(LAS unsigned char* lds, const bf16* proj, const float* gates, bf16* ST, float* G_arr, float* A_arr, float* NU) {
    const int tid = tid_opaque(), lane = tid & 63, wid = __builtin_amdgcn_readfirstlane(tid >> 6);
    LAS unsigned char* KT = lds; LAS unsigned char* VT = lds + 17408; LAS float* WV = (LAS float*)(lds + 51200);
#pragma nounroll
    for (int item = blockIdx.x; item < 1024; item += gridDim.x) {
        const int c = item >> 2, h = item & 3, t0 = c * 64;
        if (wid == 0) {
            const float ig = gates[(size_t)(t0 + lane) * 8 + h], lf = gates[(size_t)(t0 + lane) * 8 + 4 + h];
            const float b = scan_add(lf, lane); const float g = __shfl(b, 63);
            const float val = g - b + ig; const float a = wave_max(val);
            WV[lane] = __expf(val - a);
            if (lane == 0) { G_arr[item] = g; A_arr[item] = a; }
        }
        __syncthreads();
        {
            const int s = tid >> 3, seg = tid & 7;
            const float sc = WV[s] * 0.08838834764831845f;
            const bf16* src = proj + (size_t)(t0 + s) * ML_N + 512 + h * 128 + seg * 16;
#pragma unroll
            for (int q = 0; q < 2; ++q) { const u32x4 raw = *(const u32x4*)(src + 8 * q); u32x4 o;
                o.x = pk2(bflo(raw.x) * sc, bfhi(raw.x) * sc); o.y = pk2(bflo(raw.y) * sc, bfhi(raw.y) * sc); o.z = pk2(bflo(raw.z) * sc, bfhi(raw.z) * sc); o.w = pk2(bflo(raw.w) * sc, bfhi(raw.w) * sc);
                *(LAS u32x4*)(KT + s * 272 + seg * 32 + q * 16) = o; }
            const bf16* sv = proj + (size_t)(t0 + s) * ML_N + 1024 + h * 256 + seg * 32;
#pragma unroll
            for (int q = 0; q < 4; ++q) *(LAS u32x4*)(VT + s * 528 + seg * 64 + q * 16) = *(const u32x4*)(sv + 8 * q);
        }
        __syncthreads();
        if (tid < 128) { float sum = 0.f;
#pragma unroll 8
            for (int s = 0; s < 64; ++s) sum += bf2f(*(const LAS unsigned short*)(KT + s * 272 + tid * 2));
            NU[(size_t)item * 128 + tid] = sum; }
        f32x4 acc[2][8];
#pragma unroll
        for (int mi = 0; mi < 2; ++mi)
#pragma unroll
            for (int nb = 0; nb < 8; ++nb) acc[mi][nb] = (f32x4){0.f, 0.f, 0.f, 0.f};
#pragma unroll
        for (int ks = 0; ks < 2; ++ks) {
            bf16x8 af[2];
#pragma unroll
            for (int mi = 0; mi < 2; ++mi) af[mi] = frag_tr(VT, 528, 32 * ks, 32 * wid + 16 * mi, lane);
#pragma unroll
            for (int nb = 0; nb < 8; ++nb) { const bf16x8 bfr = frag_tr(KT, 272, 32 * ks, 16 * nb, lane);
#pragma unroll
                for (int mi = 0; mi < 2; ++mi) acc[mi][nb] = MFMA16(bfr, af[mi], acc[mi][nb]); }
        }
        bf16* dst = ST + (size_t)item * 32768;
#pragma unroll
        for (int mi = 0; mi < 2; ++mi)
#pragma unroll
            for (int nb = 0; nb < 8; ++nb) { const int v = 32 * wid + 16 * mi + (lane & 15), d = 16 * nb + 4 * (lane >> 4);
                u32x2 w; w.x = pk2(acc[mi][nb].x, acc[mi][nb].y); w.y = pk2(acc[mi][nb].z, acc[mi][nb].w); *(u32x2*)(dst + v * 128 + d) = w; }
        __syncthreads();
    }
}

__device__ __forceinline__ void ml_phase2(bf16* ST, const float* G_arr, const float* A_arr, float* M_arr, float* NU) {
    for (int e = blockIdx.x * 512 + tid_opaque(); e < 131072; e += gridDim.x * 512) {
        const int h = e >> 15, idx = e & 32767;
        const bool do_n = idx < 128;
        float m = 0.f, st = 0.f, nst = 0.f;
        for (int c0 = 0; c0 < 256; c0 += 8) {
            unsigned short u[8]; float nu[8];
#pragma unroll
            for (int j = 0; j < 8; ++j) { u[j] = ST[(size_t)((c0 + j) * 4 + h) * 32768 + idx]; nu[j] = do_n ? NU[(size_t)((c0 + j) * 4 + h) * 128 + idx] : 0.f; }
#pragma unroll
            for (int j = 0; j < 8; ++j) {
                const int ci = (c0 + j) * 4 + h;
                const float g = G_arr[ci], a = A_arr[ci];
                if (idx == 0) M_arr[ci] = m;
                ST[(size_t)ci * 32768 + idx] = (unsigned short)f2bf(st);
                if (do_n) NU[(size_t)ci * 128 + idx] = nst;
                const float mn = fmaxf(g + m, a), dec = __expf(g + m - mn), add = __expf(a - mn);
                st = dec * st + add * bf2f(u[j]); nst = dec * nst + add * nu[j]; m = mn;
            }
        }
    }
}

__device__ __forceinline__ void ml_phase3(LAS unsigned char* lds, const bf16* proj, const float* gates, const bf16* ST, const float* M_arr, const float* NS,
                                          const float* normw, bf16* HS) {
    const int tid = tid_opaque(), lane = tid & 63, wid = __builtin_amdgcn_readfirstlane(tid >> 6);
    const int li = lane & 15, lg = lane >> 4;
    LAS unsigned char* Q = lds; LAS unsigned char* K = lds + 17408; LAS unsigned char* V = lds + 34816; LAS unsigned char* SM = lds + 68608;
    LAS float* ROWT = (LAS float*)(lds + 77824); LAS float* COLT = ROWT + 64; LAS float* INTER = ROWT + 128; LAS float* EMT = ROWT + 192; LAS float* DEN = ROWT + 256;
    LAS float* NV = ROWT + 320;
    LAS float* SSQ = ROWT + 448;
#pragma nounroll
    for (int item = blockIdx.x; item < 1024; item += gridDim.x) {
        const int c = item >> 2, h = item & 3, t0 = c * 64;
        if (wid == 0) {
            const float ig = gates[(size_t)(t0 + lane) * 8 + h], lf = gates[(size_t)(t0 + lane) * 8 + 4 + h];
            const float b = scan_add(lf, lane);
            const float ct = ig - b; const float pm = scan_max(ct, lane);
            const float mc = M_arr[item];
            const float mt = fmaxf(b + pm, b + mc);
            ROWT[lane] = b - mt; COLT[lane] = ct; INTER[lane] = __expf(b + mc - mt); EMT[lane] = __expf(-mt);
        }
        {
            const int s = tid >> 3, seg = tid & 7;
            const bf16* rowp = proj + (size_t)(t0 + s) * ML_N;
            const bf16* sq = rowp + h * 128 + seg * 16; const bf16* sk = rowp + 512 + h * 128 + seg * 16; const bf16* sv = rowp + 1024 + h * 256 + seg * 32;
#pragma unroll
            for (int q = 0; q < 2; ++q) { *(LAS u32x4*)(Q + s * 272 + seg * 32 + q * 16) = *(const u32x4*)(sq + 8 * q); *(LAS u32x4*)(K + s * 272 + seg * 32 + q * 16) = *(const u32x4*)(sk + 8 * q); }
#pragma unroll
            for (int q = 0; q < 4; ++q) *(LAS u32x4*)(V + s * 528 + seg * 64 + q * 16) = *(const u32x4*)(sv + 8 * q);
            if (tid < 128) NV[tid] = NS[(size_t)item * 128 + tid];
        }
        __syncthreads();
        {
            const int mb = wid >> 1;
            f32x4 sa[2] = {(f32x4){0.f, 0.f, 0.f, 0.f}, (f32x4){0.f, 0.f, 0.f, 0.f}};
#pragma unroll
            for (int ks = 0; ks < 4; ++ks) { const bf16x8 af = frag_row(Q, 272, 16 * mb, 32 * ks, lane);
#pragma unroll
                for (int q = 0; q < 2; ++q) { const bf16x8 bfr = frag_row(K, 272, 16 * (2 * (wid & 1) + q), 32 * ks, lane); sa[q] = MFMA16(bfr, af, sa[q]); } }
            const int t = 16 * mb + li; const float rt = ROWT[t];
#pragma unroll
            for (int q = 0; q < 2; ++q) { const int s0 = 16 * (2 * (wid & 1) + q) + 4 * lg; float o[4];
#pragma unroll
                for (int j = 0; j < 4; ++j) { const int s = s0 + j; o[j] = (s <= t) ? sa[q][j] * 0.08838834764831845f * __expf(rt + COLT[s]) : 0.f; }
                u32x2 w; w.x = pk2(o[0], o[1]); w.y = pk2(o[2], o[3]); *(LAS u32x2*)(SM + t * 144 + s0 * 2) = w; }
        }
        __syncthreads();
        {
            const int t = tid >> 3, seg = tid & 7;
            const u32x4 sr = *(const LAS u32x4*)(SM + t * 144 + seg * 16);
            float d1 = (bflo(sr.x) + bfhi(sr.x)) + (bflo(sr.y) + bfhi(sr.y)) + (bflo(sr.z) + bfhi(sr.z)) + (bflo(sr.w) + bfhi(sr.w));
            float d2 = 0.f;
#pragma unroll
            for (int q = 0; q < 2; ++q) { const u32x4 qr = *(const LAS u32x4*)(Q + t * 272 + seg * 32 + q * 16); const LAS float* nv = NV + seg * 16 + q * 8;
                d2 += bflo(qr.x) * nv[0] + bfhi(qr.x) * nv[1] + bflo(qr.y) * nv[2] + bfhi(qr.y) * nv[3] + bflo(qr.z) * nv[4] + bfhi(qr.z) * nv[5] + bflo(qr.w) * nv[6] + bfhi(qr.w) * nv[7]; }
            float dd = d1 + INTER[t] * d2;
            dd += __shfl_xor(dd, 1); dd += __shfl_xor(dd, 2); dd += __shfl_xor(dd, 4);
            if (seg == 0) DEN[t] = dd;
        }
        f32x4 acc[4][2];
#pragma unroll
        for (int mb = 0; mb < 4; ++mb) { acc[mb][0] = (f32x4){0.f, 0.f, 0.f, 0.f}; acc[mb][1] = acc[mb][0]; }
        {
            const bf16* ct = ST + (size_t)item * 32768 + (size_t)(32 * wid + li) * 128 + 8 * lg;
#pragma unroll
            for (int ks = 0; ks < 4; ++ks) {
                bf16x8 bfr[2];
#pragma unroll
                for (int nb = 0; nb < 2; ++nb) bfr[nb] = *(const bf16x8*)(ct + nb * 16 * 128 + 32 * ks);
#pragma unroll
                for (int mb = 0; mb < 4; ++mb) { const bf16x8 af = frag_row(Q, 272, 16 * mb, 32 * ks, lane);
#pragma unroll
                    for (int nb = 0; nb < 2; ++nb) acc[mb][nb] = MFMA16(bfr[nb], af, acc[mb][nb]); }
            }
#pragma unroll
            for (int mb = 0; mb < 4; ++mb) { const float it = INTER[16 * mb + li]; acc[mb][0] *= it; acc[mb][1] *= it; }
#pragma unroll
            for (int ks = 0; ks < 2; ++ks) {
                bf16x8 bfr[2];
#pragma unroll
                for (int nb = 0; nb < 2; ++nb) bfr[nb] = frag_tr(V, 528, 32 * ks, 32 * wid + 16 * nb, lane);
#pragma unroll
                for (int mb = 0; mb < 4; ++mb) { const bf16x8 af = frag_row(SM, 144, 16 * mb, 32 * ks, lane);
#pragma unroll
                    for (int nb = 0; nb < 2; ++nb) acc[mb][nb] = MFMA16(bfr[nb], af, acc[mb][nb]); }
            }
        }
        __syncthreads();
#pragma unroll
        for (int mb = 0; mb < 4; ++mb) {
            const int t = 16 * mb + li;
            const float rd = 1.0f / fmaxf(fabsf(DEN[t]), EMT[t]);
            acc[mb][0] *= rd; acc[mb][1] *= rd;
            float q = 0.f;
#pragma unroll
            for (int nb = 0; nb < 2; ++nb) q += (acc[mb][nb].x * acc[mb][nb].x + acc[mb][nb].y * acc[mb][nb].y) + (acc[mb][nb].z * acc[mb][nb].z + acc[mb][nb].w * acc[mb][nb].w);
            q += __shfl_xor(q, 16); q += __shfl_xor(q, 32);
            if (lg == 0) SSQ[t * 8 + wid] = q;
        }
        __syncthreads();
#pragma unroll
        for (int mb = 0; mb < 4; ++mb) {
            const int t = 16 * mb + li;
            const f32x4 p0 = *(const LAS f32x4*)(SSQ + t * 8), p1 = *(const LAS f32x4*)(SSQ + t * 8 + 4);
            const float rstd = rsqrtf(((p0.x + p0.y) + (p0.z + p0.w) + (p1.x + p1.y) + (p1.z + p1.w)) * (1.0f / 256.0f) + EPS);
#pragma unroll
            for (int nb = 0; nb < 2; ++nb) {
                const int col = h * 256 + 32 * wid + 16 * nb + 4 * lg;
                const u32x2 ov = *(const u32x2*)(proj + (size_t)(t0 + t) * ML_N + 2048 + col);
                const f32x4 nw = *(const f32x4*)(normw + col);
                const f32x4 a = acc[mb][nb];
                u32x2 w; w.x = pk2(a.x * rstd * nw.x * sigmoidf_(bflo(ov.x)), a.y * rstd * nw.y * sigmoidf_(bfhi(ov.x)));
                w.y = pk2(a.z * rstd * nw.z * sigmoidf_(bflo(ov.y)), a.w * rstd * nw.w * sigmoidf_(bfhi(ov.y)));
                *(u32x2*)(HS + (size_t)(t0 + t) * D + col) = w;
            }
        }
        __syncthreads();
    }
}

__device__ __forceinline__ void conv8(const bf16* proj, const float* cw, const float* cb, int t, int j0, float (&o)[8]) {
    const f32x4 b0 = *(const f32x4*)(cb + j0), b1 = *(const f32x4*)(cb + j0 + 4);
    o[0] = b0.x; o[1] = b0.y; o[2] = b0.z; o[3] = b0.w; o[4] = b1.x; o[5] = b1.y; o[6] = b1.z; o[7] = b1.w;
#pragma unroll
    for (int tap = 0; tap < 4; ++tap) {
        const int tt = t - 3 + tap;
        if (tt >= 0) {
            const u32x4 raw = *(const u32x4*)(proj + (size_t)tt * MB_N + 2048 + j0);
            const f32x4 w0 = *(const f32x4*)(cw + tap * 3072 + j0), w1 = *(const f32x4*)(cw + tap * 3072 + j0 + 4);
            o[0] += w0.x * bflo(raw.x); o[1] += w0.y * bfhi(raw.x); o[2] += w0.z * bflo(raw.y); o[3] += w0.w * bfhi(raw.y);
            o[4] += w1.x * bflo(raw.z); o[5] += w1.y * bfhi(raw.z); o[6] += w1.z * bflo(raw.w); o[7] += w1.w * bfhi(raw.w);
        }
    }
#pragma unroll
    for (int e = 0; e < 8; ++e) o[e] = silu(o[e]);
}
__device__ __forceinline__ void conv8_store(LAS unsigned char* dst, const bf16* proj, const float* cw, const float* cb, int t, int j0, float sc) {
    float o[8]; conv8(proj, cw, cb, t, j0, o);
    u32x4 w; w.x = pk2(o[0] * sc, o[1] * sc); w.y = pk2(o[2] * sc, o[3] * sc); w.z = pk2(o[4] * sc, o[5] * sc); w.w = pk2(o[6] * sc, o[7] * sc);
    *(LAS u32x4*)dst = w;
}

__device__ __forceinline__ void mb_phase1(LAS unsigned char* lds, const bf16* proj, const float* cw, const float* cb, const float* dtb, const float* Alog,
                                          bf16* ST, float* ACUM, float* DT, float* ALAST) {
    const int tid = tid_opaque(), lane = tid & 63, wid = __builtin_amdgcn_readfirstlane(tid >> 6);
    LAS unsigned char* BC = lds; LAS unsigned char* XS = lds + 34816; LAS float* WSC = (LAS float*)(lds + 71680);
#pragma nounroll
    for (int item = blockIdx.x; item < 512; item += gridDim.x) {
        const int c = item >> 2, g = item & 3, t0 = c * 128;
        {
            const int hd = 8 * g + wid; const float A = -__expf(Alog[hd]), bias = dtb[hd];
            const int r0 = 2 * lane;
            const float dt0 = softplus_(bf2f(proj[(size_t)(t0 + r0) * MB_N + 5120 + hd]) + bias), dt1 = softplus_(bf2f(proj[(size_t)(t0 + r0 + 1) * MB_N + 5120 + hd]) + bias);
            const float da0 = dt0 * A, da1 = dt1 * A;
            const float inc = scan_add(da0 + da1, lane);
            const float a1 = inc, a0 = inc - da1, al = __shfl(inc, 63);
            ACUM[(size_t)(t0 + r0) * 32 + hd] = a0; ACUM[(size_t)(t0 + r0 + 1) * 32 + hd] = a1;
            DT[(size_t)(t0 + r0) * 32 + hd] = dt0; DT[(size_t)(t0 + r0 + 1) * 32 + hd] = dt1;
            WSC[wid * 128 + r0] = __expf(al - a0) * dt0; WSC[wid * 128 + r0 + 1] = __expf(al - a1) * dt1;
            if (lane == 63) ALAST[c * 32 + hd] = al;
        }
        {
            const int s = tid >> 2, seg = tid & 3;
#pragma unroll
            for (int q = 0; q < 4; ++q) conv8_store(BC + s * 272 + seg * 64 + q * 16, proj, cw, cb, t0 + s, 2048 + g * 128 + seg * 32 + q * 8, 1.0f);
        }
        __syncthreads();
        bf16x8 bfr[4];
#pragma unroll
        for (int ks = 0; ks < 4; ++ks) bfr[ks] = frag_tr(BC, 272, 32 * ks, 16 * wid, lane);
#pragma nounroll
        for (int hl = 0; hl < 8; ++hl) {
            LAS unsigned char* X = XS + (hl & 1) * 18432;
            const int hd = 8 * g + hl;
            {
                const int s = tid >> 2, seg = tid & 3; const float sc = WSC[hl * 128 + s];
#pragma unroll
                for (int q = 0; q < 2; ++q) conv8_store(X + s * 144 + seg * 32 + q * 16, proj, cw, cb, t0 + s, hd * 64 + seg * 16 + q * 8, sc);
            }
            __syncthreads();
            f32x4 acc[4];
#pragma unroll
            for (int mb = 0; mb < 4; ++mb) acc[mb] = (f32x4){0.f, 0.f, 0.f, 0.f};
#pragma unroll
            for (int ks = 0; ks < 4; ++ks)
#pragma unroll
                for (int mb = 0; mb < 4; ++mb) { const bf16x8 af = frag_tr(X, 144, 32 * ks, 16 * mb, lane); acc[mb] = MFMA16(bfr[ks], af, acc[mb]); }
            bf16* dst = ST + (size_t)(c * 32 + hd) * 8192;
#pragma unroll
            for (int mb = 0; mb < 4; ++mb) { const int p = 16 * mb + (lane & 15), n = 16 * wid + 4 * (lane >> 4);
                u32x2 w; w.x = pk2(acc[mb].x, acc[mb].y); w.y = pk2(acc[mb].z, acc[mb].w); *(u32x2*)(dst + p * 128 + n) = w; }
        }
        __syncthreads();
    }
}

__device__ __forceinline__ void mb_phase2(bf16* ST, const float* ALAST) {
    for (int e = blockIdx.x * 512 + tid_opaque(); e < 131072; e += gridDim.x * 512) {
        const int hd = e >> 12, idx = (e & 4095) * 2;
        float s0 = 0.f, s1 = 0.f;
        for (int c0 = 0; c0 < 128; c0 += 8) {
            unsigned u[8];
#pragma unroll
            for (int j = 0; j < 8; ++j) u[j] = *(const unsigned*)(ST + (size_t)((c0 + j) * 32 + hd) * 8192 + idx);
#pragma unroll
            for (int j = 0; j < 8; ++j) {
                const int ci = (c0 + j) * 32 + hd;
                *(unsigned*)(ST + (size_t)ci * 8192 + idx) = pk2(s0, s1);
                const float dec = __expf(ALAST[ci]);
                s0 = dec * s0 + bflo(u[j]); s1 = dec * s1 + bfhi(u[j]);
            }
        }
    }
}

__device__ __forceinline__ void mb_phase3(LAS unsigned char* lds, const bf16* proj, const float* cw, const float* cb, const float* Dsk, const float* normw,
                                          const bf16* ST, const float* ACUM, const float* DT, bf16* YO) {
    const int tid = tid_opaque(), lane = tid & 63, wid = __builtin_amdgcn_readfirstlane(tid >> 6);
    const int li = lane & 15, lg = lane >> 4;
    LAS unsigned char* CC = lds; LAS unsigned char* RB = lds + 34816; LAS unsigned char* XS = RB; LAS unsigned char* STT = RB + 18432;
    LAS unsigned char* WW = lds + 71680 + wid * 4352;
    LAS float* AA = (LAS float*)(lds + 106496); LAS float* DD = AA + 1024;
#pragma nounroll
    for (int item = blockIdx.x; item < 512; item += gridDim.x) {
        const int c = item >> 2, g = item & 3, t0 = c * 128;
        {
            const int s = tid >> 2, seg = tid & 3;
#pragma unroll
            for (int q = 0; q < 4; ++q) {
                conv8_store(CC + s * 272 + seg * 64 + q * 16, proj, cw, cb, t0 + s, 2048 + 512 + g * 128 + seg * 32 + q * 8, 1.0f);
                conv8_store(RB + s * 272 + seg * 64 + q * 16, proj, cw, cb, t0 + s, 2048 + g * 128 + seg * 32 + q * 8, 1.0f);
            }
#pragma unroll
            for (int q = 0; q < 2; ++q) { const int hl = seg * 2 + q; AA[hl * 128 + s] = ACUM[(size_t)(t0 + s) * 32 + 8 * g + hl]; DD[hl * 128 + s] = DT[(size_t)(t0 + s) * 32 + 8 * g + hl]; }
        }
        __syncthreads();
        bf16x8 cf[4];
#pragma unroll
        for (int ks = 0; ks < 4; ++ks) cf[ks] = frag_row(CC, 272, 16 * wid, 32 * ks, lane);
        f32x4 G[8];
#pragma unroll
        for (int nb = 0; nb < 8; ++nb) {
            G[nb] = (f32x4){0.f, 0.f, 0.f, 0.f};
            if (nb <= wid) {
#pragma unroll
                for (int ks = 0; ks < 4; ++ks) { const bf16x8 bfr = frag_row(RB, 272, 16 * nb, 32 * ks, lane); G[nb] = MFMA16(bfr, cf[ks], G[nb]); }
            }
        }
        __syncthreads();
        const int t = 16 * wid + li;
        float ssq = 0.f;
#pragma nounroll
        for (int hl = 0; hl < 8; ++hl) {
            const int hd = 8 * g + hl;
            {
                const int s = tid >> 2, seg = tid & 3;
#pragma unroll
                for (int q = 0; q < 2; ++q) conv8_store(XS + s * 144 + seg * 32 + q * 16, proj, cw, cb, t0 + s, hd * 64 + seg * 16 + q * 8, 1.0f);
                const int p = tid >> 3, sg = tid & 7;
                const bf16* sp = ST + (size_t)(c * 32 + hd) * 8192 + p * 128 + sg * 16;
#pragma unroll
                for (int q = 0; q < 2; ++q) *(LAS u32x4*)(STT + p * 272 + sg * 32 + q * 16) = *(const u32x4*)(sp + 8 * q);
            }
            __syncthreads();
            const float at = AA[hl * 128 + t];
            f32x4 acc[4];
#pragma unroll
            for (int nb = 0; nb < 4; ++nb) acc[nb] = (f32x4){0.f, 0.f, 0.f, 0.f};
#pragma unroll
            for (int ks = 0; ks < 4; ++ks)
#pragma unroll
                for (int nb = 0; nb < 4; ++nb) { const bf16x8 bfr = frag_row(STT, 272, 16 * nb, 32 * ks, lane); acc[nb] = MFMA16(bfr, cf[ks], acc[nb]); }
            { const float ea = __expf(at);
#pragma unroll
              for (int nb = 0; nb < 4; ++nb) acc[nb] *= ea; }
#pragma unroll
            for (int nb = 0; nb < 8; ++nb) {
                const int s0 = 16 * nb + 4 * lg; float o[4];
                const f32x4 as = *(const LAS f32x4*)(AA + hl * 128 + s0), ds = *(const LAS f32x4*)(DD + hl * 128 + s0);
#pragma unroll
                for (int j = 0; j < 4; ++j) { const int s = s0 + j; o[j] = (s <= t) ? G[nb][j] * __expf(at - as[j]) * ds[j] : 0.f; }
                u32x2 w; w.x = pk2(o[0], o[1]); w.y = pk2(o[2], o[3]); *(LAS u32x2*)(WW + li * 272 + s0 * 2) = w;
            }
            for (int ks = 0; ks <= (wid >> 1); ++ks) {
                const bf16x8 af = frag_row(WW, 272, 0, 32 * ks, lane);
#pragma unroll
                for (int nb = 0; nb < 4; ++nb) { const bf16x8 bfr = frag_tr(XS, 144, 32 * ks, 16 * nb, lane); acc[nb] = MFMA16(bfr, af, acc[nb]); }
            }
            const float dsk = Dsk[hd];
#pragma unroll
            for (int nb = 0; nb < 4; ++nb) {
                const int p0 = 16 * nb + 4 * lg;
                const u32x2 xv = *(const LAS u32x2*)(XS + t * 144 + p0 * 2);
                const u32x2 zv = *(const u32x2*)(proj + (size_t)(t0 + t) * MB_N + hd * 64 + p0);
                f32x4 yv;
                yv.x = (acc[nb].x + dsk * bflo(xv.x)) * silu(bflo(zv.x)); yv.y = (acc[nb].y + dsk * bfhi(xv.x)) * silu(bfhi(zv.x));
                yv.z = (acc[nb].z + dsk * bflo(xv.y)) * silu(bflo(zv.y)); yv.w = (acc[nb].w + dsk * bfhi(xv.y)) * silu(bfhi(zv.y));
                ssq += (yv.x * yv.x + yv.y * yv.y) + (yv.z * yv.z + yv.w * yv.w);
                u32x2 w; w.x = pk2(yv.x, yv.y); w.y = pk2(yv.z, yv.w);
                *(u32x2*)(YO + (size_t)(t0 + t) * MB_DI + hd * 64 + p0) = w;
            }
            __syncthreads();
        }
        ssq += __shfl_xor(ssq, 16); ssq += __shfl_xor(ssq, 32);
        const float rstd = rsqrtf(ssq * (1.0f / 512.0f) + EPS);
#pragma nounroll
        for (int hl = 0; hl < 8; ++hl) {
#pragma unroll
            for (int nb = 0; nb < 4; ++nb) {
                const int col = (8 * g + hl) * 64 + 16 * nb + 4 * lg;
                bf16* yp = YO + (size_t)(t0 + t) * MB_DI + col;
                const u32x2 yv = *(const u32x2*)yp; const f32x4 nw = *(const f32x4*)(normw + col);
                u32x2 w; w.x = pk2(bflo(yv.x) * rstd * nw.x, bfhi(yv.x) * rstd * nw.y); w.y = pk2(bflo(yv.y) * rstd * nw.z, bfhi(yv.y) * rstd * nw.w);
                *(u32x2*)yp = w;
            }
        }
        __syncthreads();
    }
}

#ifndef SYNC_REP
#define SYNC_REP 1
#endif
#ifndef GEMM_REP
#define GEMM_REP 1
#endif
#ifndef MIX_REP
#define MIX_REP 1
#endif
#define GSYNC() do { for (int r_ = 0; r_ < SYNC_REP; ++r_) xcd_barrier(xbar); } while (0)
template <class Epi>
__device__ __forceinline__ void run_gemm(LAS unsigned char* lds, const bf16* A, const bf16* Bt, int N, int K, const Epi& E) {
    pg8::Gemm g{A, Bt, S, N, K}; pg8::StaticOrder so; so.init(S, N, (int)gridDim.x, (int)blockIdx.x);
    for (int r_ = 0; r_ < GEMM_REP; ++r_) pg8::gemm_phase<Epi, pg8::StaticOrder, true, true>(lds, g, so, E);
}

template <int I, int SUB>
__device__ __forceinline__ void sublayer(LAS unsigned char* lds, const Params& P, const XcdBarrier& xbar) {
    unsigned char* ws = P.ws;
    float* MOD = (float*)(ws + WS_MOD); float* GATES = (float*)(ws + WS_GATES);
    float* G_arr = (float*)(ws + WS_MISC + MI_G); float* A_arr = (float*)(ws + WS_MISC + MI_A); float* M_arr = (float*)(ws + WS_MISC + MI_M);
    float* NU = (float*)(ws + WS_MISC + MI_NU); float* ALAST = (float*)(ws + WS_MISC + MI_ALAST);
    float* ACUM = (float*)(ws + WS_ACUM); float* DTB = (float*)(ws + WS_DT);
    bf16* HM = (bf16*)(ws + WS_HM); bf16* PROJ = (bf16*)(ws + WS_PROJ); bf16* ST = (bf16*)(ws + WS_ST); float* Y = (float*)(ws + WS_Y);
    const float* npre = P.in[4]; const float* npost = P.in[5];
    constexpr int i = I, s = SUB, j = I >> 1; constexpr bool is_ml = (I & 1) == 0;
    const float* modi = MOD + i * 9216;
    {
        constexpr bool first = (i == 0 && s == 0);
        constexpr int pi = (s == 0) ? i - 1 : i, ps = (s == 0) ? 2 : s - 1;
        const float* pgate = first ? nullptr : MOD + pi * 9216 + (ps * 3 + 2) * 1024;
        const float* pgp = first ? nullptr : npost + (pi * 3 + ps) * 1024;
        const float* xin = (first || (i == 0 && s == 1)) ? P.in[0] : P.out;
        constexpr bool gates_on = is_ml && s == 1;
#ifndef NO_NORM
        norm_pass(lds, xin, P.out, first ? nullptr : Y, pgate, pgp, (ps == 1) ? 1.0f : 0.5f,
                  npre + (i * 3 + s) * 1024, modi + (s * 3 + 1) * 1024, modi + (s * 3 + 0) * 1024, HM,
                  gates_on ? P.in[9] + (size_t)j * D * ML_LD + 3072 : nullptr, P.in[10] + j * 8, GATES);
#endif
    }
    GSYNC();
    if constexpr (s != 1) {
        constexpr int f = (s == 0) ? 0 : 1;
        const unsigned char* wb = ws + WS_W + (size_t)(i * 2 + f) * FFN_B;
        { pg8::EpiSwiGLU E{PROJ, DFF}; run_gemm(lds, HM, (const bf16*)wb, 2 * DFF, D, E); }
        GSYNC();
        { pg8::EpiStoreF32 E{Y, D}; run_gemm(lds, PROJ, (const bf16*)(wb + FFN_UP_B), D, DFF, E); }
        GSYNC();
    } else if constexpr (is_ml) {
        { pg8::EpiStoreBf16 E{PROJ, ML_N}; run_gemm(lds, HM, (const bf16*)(ws + WS_W_ML_IN + j * ML_IN_B), ML_N, D, E); }
        GSYNC();
#ifndef NO_ML
        for (int r_ = 0; r_ < MIX_REP; ++r_) ml_phase1(lds, PROJ, GATES, ST, G_arr, A_arr, NU);
        GSYNC();
        ml_phase2(ST, G_arr, A_arr, M_arr, NU);
        GSYNC();
        for (int r_ = 0; r_ < MIX_REP; ++r_) ml_phase3(lds, PROJ, GATES, ST, M_arr, NU, P.in[11] + j * 1024, HM);
        GSYNC();
#endif
        { pg8::EpiStoreF32 E{Y, D}; run_gemm(lds, HM, (const bf16*)(ws + WS_W_ML_OUT + j * ML_OUT_B), D, D, E); }
        GSYNC();
    } else {
        { pg8::EpiStoreBf16 E{PROJ, MB_N}; run_gemm(lds, HM, (const bf16*)(ws + WS_W_MB_IN + j * MB_IN_B), MB_N, D, E); }
        GSYNC();
#ifndef NO_MB
        for (int r_ = 0; r_ < MIX_REP; ++r_) mb_phase1(lds, PROJ, P.in[14] + (size_t)j * 4 * 3072, P.in[15] + j * 3072, P.in[16] + j * 32, P.in[17] + j * 32, ST, ACUM, DTB, ALAST);
        GSYNC();
        mb_phase2(ST, ALAST);
        GSYNC();
        for (int r_ = 0; r_ < MIX_REP; ++r_) mb_phase3(lds, PROJ, P.in[14] + (size_t)j * 4 * 3072, P.in[15] + j * 3072, P.in[18] + j * 32, P.in[19] + j * 2048, ST, ACUM, DTB, HM);
        GSYNC();
#endif
        { pg8::EpiStoreF32 E{Y, D}; run_gemm(lds, HM, (const bf16*)(ws + WS_W_MB_OUT + j * MB_OUT_B), D, MB_DI, E); }
        GSYNC();
    }
}

__global__ void __launch_bounds__(512) mega_fwd(Params P) {
    extern __shared__ __attribute__((aligned(16))) unsigned char lds_raw[];
    LAS unsigned char* lds = (LAS unsigned char*)lds_raw;
    cg::grid_group grid = cg::this_grid();
    if (threadIdx.x < 16) ((LAS unsigned*)(lds + XB_LDS_OFF))[threadIdx.x] = 0u;
    __syncthreads();
    const XcdBarrier xbar = xcd_barrier_post((unsigned*)(P.ws + WS_XBAR), (volatile LAS unsigned*)(lds + XB_LDS_OFF));
#ifndef NO_PRO
    prologue(lds, P);
#endif
    grid.sync();
    sublayer<0, 0>(lds, P, xbar); sublayer<0, 1>(lds, P, xbar); sublayer<0, 2>(lds, P, xbar);
    sublayer<1, 0>(lds, P, xbar); sublayer<1, 1>(lds, P, xbar); sublayer<1, 2>(lds, P, xbar);
    sublayer<2, 0>(lds, P, xbar); sublayer<2, 1>(lds, P, xbar); sublayer<2, 2>(lds, P, xbar);
    sublayer<3, 0>(lds, P, xbar); sublayer<3, 1>(lds, P, xbar); sublayer<3, 2>(lds, P, xbar);
    {
        float* MOD = (float*)(P.ws + WS_MOD); float* Y = (float*)(P.ws + WS_Y);
        norm_pass(lds, P.out, P.out, Y, MOD + 3 * 9216 + (2 * 3 + 2) * 1024, P.in[5] + (3 * 3 + 2) * 1024, 0.5f,
                  nullptr, nullptr, nullptr, nullptr, nullptr, nullptr, nullptr);
    }
}

extern "C" void kernel_launch(void* const* d_in, const int* in_sizes, int n_in, void* d_out, int out_size, void* d_ws, size_t ws_size, hipStream_t stream) {
    static int grid_blocks = 0;
    if (grid_blocks == 0) {
        if (n_in != 21 || ws_size < WS_END) { fprintf(stderr, "kernel_launch: unexpected n_in %d / ws_size %zu (need %zu)\n", n_in, ws_size, (size_t)WS_END); grid_blocks = -1; return; }
        int dev = 0, cus = 0, per_cu = 0;
        hipGetDevice(&dev);
        hipDeviceGetAttribute(&cus, hipDeviceAttributeMultiprocessorCount, dev);
        hipFuncSetAttribute((const void*)mega_fwd, hipFuncAttributeMaxDynamicSharedMemorySize, LDS_BYTES);
        hipOccupancyMaxActiveBlocksPerMultiprocessor(&per_cu, (const void*)mega_fwd, 512, LDS_BYTES);
        if (per_cu < 1) per_cu = 1;
        grid_blocks = cus * per_cu;
        (void)hipGetLastError();
    }
    if (grid_blocks < 0) return;
    if (hipMemsetAsync((char*)d_ws + WS_XBAR, 0, 16384, stream) != hipSuccess) { fprintf(stderr, "memset failed\n"); return; }
    Params p{};
    for (int i = 0; i < 21; ++i) p.in[i] = (const float*)d_in[i];
    p.out = (float*)d_out; p.ws = (unsigned char*)d_ws;
    void* args[] = {&p};
    hipError_t e = hipLaunchCooperativeKernel((const void*)mega_fwd, dim3(grid_blocks), dim3(512), args, LDS_BYTES, stream);
    if (e != hipSuccess) fprintf(stderr, "cooperative launch failed: %s (grid %d)\n", hipGetErrorString(e), grid_blocks);
}
```
